# Optimizing an MI355X kernel written in HIP

```python
import math
import jax, jax.numpy as jnp
from jax import lax
import numpy as np

D_MODEL = 1024
BATCH = 8
SEQ = 2048
DEPTH = 4

HEAD_DIM = 64
A_GROUPS = ((128, 1), (512, 4), (2048, 16))
A_HEADS_PER_GROUP = 4
A_HEADS = A_HEADS_PER_GROUP * len(A_GROUPS)
A_WIDTH = A_HEADS * HEAD_DIM
B_HEADS = D_MODEL // HEAD_DIM
B_WIDTH = B_HEADS * HEAD_DIM
N_A = DEPTH // 2
N_B = DEPTH - N_A
D_FF = 2816
CONV_W = 3
ROPE_DIM = HEAD_DIM // 4
ROPE_THETA = 500000.0
BLK = 128
EPS = 1e-6
NEG = -1e30

kernel_name = "yoco_dilated_fox_convffn_trunk"


def rms_norm(x, g):
    x32 = x.astype(jnp.float32)
    y = x32 * lax.rsqrt(jnp.mean(x32 * x32, axis=-1, keepdims=True) + EPS)
    return (y * g.astype(jnp.float32)).astype(x.dtype)


def rope_tables(T):
    pos = jnp.arange(T, dtype=jnp.float32)
    inv = ROPE_THETA ** (-jnp.arange(0, ROPE_DIM, 2, dtype=jnp.float32) / ROPE_DIM)
    ang = pos[:, None] * inv[None, :]
    return jnp.cos(ang), jnp.sin(ang)


def apply_rope(t, cos, sin):
    half = ROPE_DIM // 2
    c = cos[None, :, None, :].astype(t.dtype)
    s = sin[None, :, None, :].astype(t.dtype)
    x1 = t[..., :half]
    x2 = t[..., half:ROPE_DIM]
    return jnp.concatenate([x1 * c - x2 * s, x2 * c + x1 * s, t[..., ROPE_DIM:]], axis=-1)


def banded_attention(q, k, v, n_back):
    N, L, H, D = q.shape
    nb = L // BLK
    qb = q.reshape(N, nb, BLK, H, D)
    kb = k.reshape(N, nb, BLK, H, D)
    vb = v.reshape(N, nb, BLK, H, D)

    def with_prev(t):
        prev = jnp.pad(t[:, :-1], ((0, 0), (1, 0), (0, 0), (0, 0), (0, 0)))
        return jnp.concatenate([prev, t], axis=2)

    kc, vc = with_prev(kb), with_prev(vb)
    s = jnp.einsum('nbqhd,nbkhd->nbhqk', qb, kc).astype(jnp.float32) * (D ** -0.5)
    rel = (jnp.arange(BLK)[:, None] + BLK) - jnp.arange(2 * BLK)[None, :]
    band = (rel >= 0) & (rel <= n_back)
    has_prev = (jnp.arange(nb)[:, None, None] > 0) | (jnp.arange(2 * BLK)[None, None, :] >= BLK)
    mask = band[None] & has_prev
    s = jnp.where(mask[None, :, None], s, NEG)
    m = jnp.max(s, axis=-1, keepdims=True)
    p = jnp.exp(s - m)
    l = jnp.sum(p, axis=-1, keepdims=True)
    o = jnp.einsum('nbhqk,nbkhd->nbqhd', (p / l).astype(v.dtype), vc)
    lse = (m + jnp.log(l))[..., 0]
    return o.reshape(N, L, H, D), lse.transpose(0, 1, 3, 2).reshape(N, L, H)


def dilated_mixer(xn, w_qkv, w_o, cos, sin):
    B, T, _ = xn.shape
    qkv = xn @ w_qkv
    q, k, v = jnp.split(qkv, 3, axis=-1)
    q = apply_rope(q.reshape(B, T, A_HEADS, HEAD_DIM), cos, sin)
    k = apply_rope(k.reshape(B, T, A_HEADS, HEAD_DIM), cos, sin)
    v = v.reshape(B, T, A_HEADS, HEAD_DIM)
    G = A_HEADS_PER_GROUP
    outs, lses = [], []
    for g, (window, r) in enumerate(A_GROUPS):
        L = T // r
        Lp = -(-L // BLK) * BLK

        def gather(t):
            t = t[:, :, g * G:(g + 1) * G].reshape(B, L, r, G, HEAD_DIM)
            t = t.transpose(0, 2, 1, 3, 4).reshape(B * r, L, G, HEAD_DIM)
            return jnp.pad(t, ((0, 0), (0, Lp - L), (0, 0), (0, 0)))

        o, lse = banded_attention(gather(q), gather(k), gather(v), window // r)
        o = o[:, :L].reshape(B, r, L, G, HEAD_DIM).transpose(0, 2, 1, 3, 4).reshape(B, T, G, HEAD_DIM)
        lse = lse[:, :L].reshape(B, r, L, G).transpose(0, 2, 1, 3).reshape(B, T, G)
        outs.append(o)
        lses.append(lse)
    alpha = jax.nn.softmax(jnp.stack(lses, axis=0), axis=0)
    o = jnp.concatenate([outs[g] * alpha[g][..., None].astype(outs[g].dtype)
                         for g in range(len(A_GROUPS))], axis=2)
    return o.reshape(B, T, A_WIDTH) @ w_o


def fox_mixer(xn, w_q, w_o, k, v, c):
    B, T, _ = xn.shape
    q = (xn @ w_q).reshape(B, T, B_HEADS, HEAD_DIM)
    c_t = c.transpose(0, 2, 1)
    scale = HEAD_DIM ** -0.5
    outs = []
    for i in range(T // BLK):
        q0, q1 = i * BLK, (i + 1) * BLK
        s = jnp.einsum('bqhd,bkhd->bhqk', q[:, q0:q1], k[:, :q1]).astype(jnp.float32) * scale
        s = s + (c_t[:, :, q0:q1, None] - c_t[:, :, None, :q1])
        causal = jnp.arange(q0, q1)[:, None] >= jnp.arange(q1)[None, :]
        s = jnp.where(causal, s, NEG)
        p = jax.nn.softmax(s, axis=-1).astype(v.dtype)
        outs.append(jnp.einsum('bhqk,bkhd->bqhd', p, v[:, :q1]))
    o = jnp.concatenate(outs, axis=1)
    return o.reshape(B, T, B_WIDTH) @ w_o


def conv_ffn(xn, w_up, cw, cb, w_down):
    a = xn @ w_up
    T = a.shape[1]
    ap = jnp.pad(a, ((0, 0), (CONV_W - 1, 0), (0, 0)))
    a = sum(ap[:, j:j + T] * cw[j] for j in range(CONV_W)) + cb
    gate, val = jnp.split(a, 2, axis=-1)
    return (jax.nn.gelu(gate, approximate=True) * val) @ w_down


def setup_inputs(seed: int = 0) -> dict:
    key = jax.random.key(seed)
    ks = jax.random.split(key, 14)

    def nrm(k, shape, fan_in):
        return jax.random.normal(k, shape, jnp.float32) * fan_in ** -0.5

    return {
        "x": jax.random.normal(ks[0], (BATCH, SEQ, D_MODEL), jnp.float32),
        "norm_gains": 1.0 + 0.05 * jax.random.normal(ks[1], (DEPTH, 4, D_MODEL), jnp.float32),
        "w_qkv_a": nrm(ks[2], (N_A, D_MODEL, 3 * A_WIDTH), D_MODEL),
        "w_o_a": nrm(ks[3], (N_A, A_WIDTH, D_MODEL), A_WIDTH),
        "w_q_b": nrm(ks[4], (N_B, D_MODEL, B_WIDTH), D_MODEL),
        "w_o_b": nrm(ks[5], (N_B, B_WIDTH, D_MODEL), B_WIDTH),
        "kv_norm": 1.0 + 0.05 * jax.random.normal(ks[6], (D_MODEL,), jnp.float32),
        "w_kvf": nrm(ks[7], (D_MODEL, 2 * B_WIDTH + B_HEADS), D_MODEL),
        "b_f": 3.0 + 0.5 * jax.random.normal(ks[8], (B_HEADS,), jnp.float32),
        "w_up": nrm(ks[9], (DEPTH, D_MODEL, 2 * D_FF), D_MODEL),
        "conv_w": nrm(ks[10], (DEPTH, CONV_W, 2 * D_FF), CONV_W),
        "conv_b": 0.01 * jax.random.normal(ks[11], (DEPTH, 2 * D_FF), jnp.float32),
        "w_down": nrm(ks[12], (DEPTH, D_FF, D_MODEL), D_FF),
    }


def reference(x, norm_gains, w_qkv_a, w_o_a, w_q_b, w_o_b, kv_norm, w_kvf, b_f,
              w_up, conv_w, conv_b, w_down):
    B, T, _ = x.shape
    cos, sin = rope_tables(T)
    h = x
    k_sh = v_sh = c_sh = None
    for l in range(DEPTH):
        g = norm_gains[l]
        if l < N_A:
            mix = dilated_mixer(rms_norm(h, g[0]), w_qkv_a[l], w_o_a[l], cos, sin)
        else:
            if l == N_A:
                kvf = rms_norm(h, kv_norm) @ w_kvf
                k_sh = kvf[..., :B_WIDTH].reshape(B, T, B_HEADS, HEAD_DIM)
                v_sh = kvf[..., B_WIDTH:2 * B_WIDTH].reshape(B, T, B_HEADS, HEAD_DIM)
                log_f = jax.nn.log_sigmoid((kvf[..., 2 * B_WIDTH:] + b_f).astype(jnp.float32))
                c_sh = jnp.cumsum(log_f, axis=1)
            j = l - N_A
            mix = fox_mixer(rms_norm(h, g[0]), w_q_b[j], w_o_b[j], k_sh, v_sh, c_sh)
        h = h + rms_norm(mix, g[1])
        f = conv_ffn(rms_norm(h, g[2]), w_up[l], conv_w[l], conv_b[l], w_down[l])
        h = h + rms_norm(f, g[3])
    return h
```

```cpp
#include <hip/hip_runtime.h>
#include <hip/hip_cooperative_groups.h>
#include <cstdio>
#include <cstdint>
#include <cmath>
namespace cg = cooperative_groups;
namespace pg8 {
#define PG8_LAS __attribute__((address_space(3)))
typedef unsigned short bf16_t;
typedef short bf16x8 __attribute__((ext_vector_type(8)));
typedef float f32x4 __attribute__((ext_vector_type(4)));
typedef unsigned u32x4 __attribute__((ext_vector_type(4)));
constexpr int BM = 256, BK = 64, HALF = 128, HTB = HALF * BK * 2  , STAGE_BYTES = 8 * HTB, NXCD = 8, WGM = 8;

__host__ __device__ __forceinline__ int lds_byte(int r, int c) { const int st = (r >> 4) * 2 + (c >> 5), rr = r & 15, cc = c & 31, ob = rr * 64 + cc * 2; return st * 1024 + (ob ^ (((ob >> 9) & 1) << 5)); }
__host__ __device__ __forceinline__ void stage_rc(int b, int& R, int& C) { const int st = b / 1024, sb = b % 1024, swz = sb ^ (((sb >> 9) & 1) << 5); R = (st >> 1) * 16 + swz / 64; C = (st & 1) * 32 + (swz % 64) / 2; }
__host__ __device__ __forceinline__ int perm32(int rho) { const int n = rho >> 4, i = rho & 15; return 8 * (i >> 2) + 4 * n + (i & 3); }

struct Unit { int pm, pn; };
struct Gemm { const bf16_t* A; const bf16_t* Bt; int M, N, K; };

struct StaticOrder {
    int nM, nN, nwg, G, c;
    __host__ __device__ void init(int M, int N, int G_, int c_) { nM = M / BM; nN = N / BM; nwg = nM * nN; G = G_; c = c_; }
    __host__ __device__ bool next(int i, Unit& u) const {
        const long L = (long)i * G + c; if (L >= nwg) return false;
        int wgid = (int)L; { const int q = nwg / NXCD, r = nwg % NXCD, xcd = wgid % NXCD, off = wgid / NXCD; wgid = (xcd < r ? xcd * (q + 1) : r * (q + 1) + (xcd - r) * q) + off; }
        const int nig = WGM * nN, gid = wgid / nig, fm = gid * WGM, gsz = (nM - fm) < WGM ? (nM - fm) : WGM;
        u.pm = fm + ((wgid % nig) % gsz); u.pn = (wgid % nig) / gsz; return true;
    }
    __device__ __forceinline__ void a_ready(const Unit&) const {}
    __device__ __forceinline__ void done(const Unit&) const {}
};

__device__ __forceinline__ unsigned cvt_pk_bf16(float lo, float hi) { unsigned r; asm volatile("v_cvt_pk_bf16_f32 %0, %1, %2" : "=v"(r) : "v"(lo), "v"(hi)); return r; }
typedef float f32x2 __attribute__((ext_vector_type(2)));
__device__ __forceinline__ f32x2 gelu_pk(f32x2 v) {
    const f32x2 av = __builtin_elementwise_abs(v), d = av * 0.2316418882f + 1.0f;
    f32x2 t; t.x = __builtin_amdgcn_rcpf(d.x); t.y = __builtin_amdgcn_rcpf(d.y);
    f32x2 q = t * 0.5307027145f + (-0.7265760135f); q = q * t + 0.7107068705f; q = q * t + (-0.142248368f); q = q * t + 0.127414796f; q = q * t;
    const f32x2 s = (v * v) * (-0.72134752044f);
    f32x2 e; e.x = __builtin_amdgcn_exp2f(s.x); e.y = __builtin_amdgcn_exp2f(s.y);
    const f32x2 m = v * (q * e), r = v - m;
    f32x2 o; o.x = v.x < 0.f ? m.x : r.x; o.y = v.y < 0.f ? m.y : r.y; return o;
}

template <int ACT  > struct EpiBf16 {
    static constexpr bool PERM = true, AFTER_DRAIN = false; static_assert(ACT == 0 || ACT == 1, "EpiBf16: ACT is 0 (none) or 1 (gelu_pk)");
    bf16_t* O; int ldc; const float* bias; int split_cols; size_t split_stride; float scale0;
    __device__ __forceinline__ void operator()(const f32x4 (&acc)[2][2][4][2], const Unit& u, int wr, int wc, int fr, int fq) const {
        const int row0 = u.pm * BM + wr * 64 + fr; int colt = u.pn * BM; bf16_t* base = O;
        float sc = 1.f; if (split_cols) { const int t = colt / split_cols; base += (size_t)t * split_stride; colt -= t * split_cols; if (t == 0) sc = scale0; }
        const int col0 = colt + wc * 32 + 8 * fq, bcol0 = u.pn * BM + wc * 32 + 8 * fq;
        f32x4 bv[2][2];
#pragma unroll
        for (int bj = 0; bj < 2; ++bj)
#pragma unroll
            for (int n = 0; n < 2; ++n) bv[bj][n] = bias ? *(const f32x4*)(bias + bcol0 + bj * HALF + 4 * n) : (f32x4){0.f, 0.f, 0.f, 0.f};
#pragma unroll
        for (int ai = 0; ai < 2; ++ai)
#pragma unroll
            for (int m = 0; m < 4; ++m) { bf16_t* rowp = base + (size_t)(row0 + ai * HALF + m * 16) * ldc + col0;
#pragma unroll
                for (int bj = 0; bj < 2; ++bj) { f32x4 v0 = acc[ai][bj][m][0] + bv[bj][0], v1 = acc[ai][bj][m][1] + bv[bj][1];
                    if (ACT == 1) { f32x2 a = gelu_pk((f32x2){v0[0], v0[1]}), b = gelu_pk((f32x2){v0[2], v0[3]}), c = gelu_pk((f32x2){v1[0], v1[1]}), d = gelu_pk((f32x2){v1[2], v1[3]});
                        v0 = (f32x4){a.x, a.y, b.x, b.y}; v1 = (f32x4){c.x, c.y, d.x, d.y}; }
                    v0 = v0 * sc; v1 = v1 * sc; u32x4 w; w.x = cvt_pk_bf16(v0[0], v0[1]); w.y = cvt_pk_bf16(v0[2], v0[3]); w.z = cvt_pk_bf16(v1[0], v1[1]); w.w = cvt_pk_bf16(v1[2], v1[3]);
                    *(u32x4*)(rowp + bj * HALF) = w; } }
    }
};
template <class Epi, class Sched, bool ALIGN_EPI = false, bool SP2 = false>
__device__ __forceinline__ void gemm_phase(PG8_LAS unsigned char* lds, const Gemm g, const Sched& S, const Epi& E) {
    const int tid = threadIdx.x, wid = __builtin_amdgcn_readfirstlane(tid >> 6), lane = tid & 63, wr = wid >> 2, wc = wid & 3, fr = lane & 15, fq = lane >> 4;
    const int K = g.K, nt = K / BK;
    unsigned voffA[2], voffB[2];
#pragma unroll
    for (int i = 0; i < 2; ++i) { int R, C; stage_rc(tid * 16 + i * 8192, R, C); const int Rb = Epi::PERM ? ((R & ~31) + perm32(R & 31)) : R;
        voffA[i] = (unsigned)(R * K + C) * 2u; voffB[i] = (unsigned)(Rb * K + C) * 2u; }
    const size_t kstep = (size_t)(BK * 2);
    const size_t hstep = (size_t)HALF * K * 2;
    const size_t tstep = 2 * hstep;
    const unsigned ldsw = (unsigned)wid * 1024u;
    const int aoff = lds_byte(wr * 64 + fr, fq * 8), boff = lds_byte(wc * 32 + fr, fq * 8);
#define PG8_SA(b, h) (((b) * 2 + (h)) * HTB)
#define PG8_SB(b, h) ((4 + (b) * 2 + (h)) * HTB)
#define PG8_STAGE(bufoff, gbase, voff) do { _Pragma("unroll") for (int _i = 0; _i < 2; ++_i) \
        __builtin_amdgcn_global_load_lds((const unsigned*)((const char*)(gbase) + (voff)[_i]), (PG8_LAS unsigned*)(lds + (bufoff) + ldsw + _i * 8192), 16, 0, 0); } while (0)
#define PG8_LDA(dst, b, h) do { _Pragma("unroll") for (int m = 0; m < 4; ++m) _Pragma("unroll") for (int k = 0; k < 2; ++k) dst[m][k] = *(const PG8_LAS bf16x8*)(lds + PG8_SA(b, h) + aoff + m * 2048 + k * 1024); } while (0)
#define PG8_LDB(dst, b, h) do { _Pragma("unroll") for (int n = 0; n < 2; ++n) _Pragma("unroll") for (int k = 0; k < 2; ++k) dst[n][k] = *(const PG8_LAS bf16x8*)(lds + PG8_SB(b, h) + boff + n * 2048 + k * 1024); } while (0)
#define PG8_MMA(ai, bj, At, Bt) do { __builtin_amdgcn_s_setprio(1); _Pragma("unroll") for (int m = 0; m < 4; ++m) _Pragma("unroll") for (int n = 0; n < 2; ++n) _Pragma("unroll") for (int k = 0; k < 2; ++k) \
        acc[ai][bj][m][n] = __builtin_amdgcn_mfma_f32_16x16x32_bf16(Bt[n][k], At[m][k], acc[ai][bj][m][n], 0, 0, 0); __builtin_amdgcn_s_setprio(0); } while (0)
#define PG8_WAIT_V(n) asm volatile("s_waitcnt vmcnt(" #n ")" ::: "memory")
#define PG8_WAIT_L(n) asm volatile("s_waitcnt lgkmcnt(" #n ")" ::: "memory")
#define PG8_BAR __builtin_amdgcn_s_barrier()
#define PG8_SCHED __builtin_amdgcn_sched_barrier(0)
    Unit cur, nxt; int ui = 0;
    if (!S.next(0, cur)) return;
    f32x4 acc[2][2][4][2];
#pragma unroll
    for (int a = 0; a < 2; ++a)
#pragma unroll
        for (int b = 0; b < 2; ++b)
#pragma unroll
            for (int m = 0; m < 4; ++m)
#pragma unroll
                for (int n = 0; n < 2; ++n) acc[a][b][m][n] = (f32x4){0.f, 0.f, 0.f, 0.f};
    bf16x8 At[4][2], B0[2][2], B1[2][2];
    const char* cA = (const char*)g.A + (size_t)cur.pm * tstep; const char* cB = (const char*)g.Bt + (size_t)cur.pn * tstep;
    S.a_ready(cur);
    if constexpr (SP2) {
        PG8_STAGE(PG8_SB(0, 0), cB, voffB); PG8_STAGE(PG8_SB(0, 1), cB + hstep, voffB); PG8_STAGE(PG8_SA(0, 0), cA, voffA); PG8_STAGE(PG8_SA(0, 1), cA + hstep, voffA);
        if (wr == 1) PG8_BAR;
        PG8_WAIT_V(2); PG8_BAR;
        PG8_STAGE(PG8_SB(1, 0), cB + kstep, voffB); PG8_STAGE(PG8_SA(1, 0), cA + kstep, voffA); PG8_STAGE(PG8_SB(1, 1), cB + hstep + kstep, voffB);
        PG8_WAIT_V(6); PG8_BAR;
    } else {
        PG8_STAGE(PG8_SB(0, 0), cB, voffB); PG8_STAGE(PG8_SA(0, 0), cA, voffA); PG8_STAGE(PG8_SB(0, 1), cB + hstep, voffB); PG8_STAGE(PG8_SA(0, 1), cA + hstep, voffA);
        if (wr == 1) PG8_BAR;
        PG8_WAIT_V(4); PG8_BAR;
        PG8_STAGE(PG8_SB(1, 0), cB + kstep, voffB); PG8_STAGE(PG8_SA(1, 0), cA + kstep, voffA); PG8_STAGE(PG8_SB(1, 1), cB + hstep + kstep, voffB);
        PG8_WAIT_V(6); PG8_BAR;
    }
    for (;;) {
        const bool has_next = S.next(ui + 1, nxt);
        const char* nA = has_next ? (const char*)g.A + (size_t)nxt.pm * tstep : cA; const char* nB = has_next ? (const char*)g.Bt + (size_t)nxt.pn * tstep : cB;
        for (int t = 0; t < nt; t += 2) {
            const bool last = (t == nt - 2);
            const char* a1 = cA + (size_t)(t + 1) * kstep;
            const char* a2 = last ? nA : cA + (size_t)(t + 2) * kstep; const char* b2 = last ? nB : cB + (size_t)(t + 2) * kstep;
            const char* a3 = a2 + kstep; const char* b3 = b2 + kstep;
            if (last && has_next) S.a_ready(nxt);
            if constexpr (SP2) {
            PG8_LDB(B0, 0, 0); PG8_LDB(B1, 0, 1); PG8_SCHED; PG8_LDA(At, 0, 0); PG8_STAGE(PG8_SA(1, 1), a1 + hstep, voffA);
            PG8_WAIT_V(8); PG8_WAIT_L(0); PG8_BAR; PG8_MMA(0, 0, At, B0); PG8_MMA(0, 1, At, B1); PG8_BAR; PG8_SCHED;
            PG8_LDA(At, 0, 1); PG8_STAGE(PG8_SB(0, 0), b2, voffB); PG8_STAGE(PG8_SB(0, 1), b2 + hstep, voffB); PG8_STAGE(PG8_SA(0, 0), a2, voffA);
            PG8_WAIT_V(8); PG8_WAIT_L(0); PG8_BAR; PG8_MMA(1, 0, At, B0); PG8_MMA(1, 1, At, B1); PG8_BAR; PG8_SCHED;
            PG8_LDB(B0, 1, 0); PG8_LDB(B1, 1, 1); PG8_SCHED; PG8_LDA(At, 1, 0); PG8_STAGE(PG8_SA(0, 1), a2 + hstep, voffA);
            PG8_WAIT_V(8); PG8_WAIT_L(0); PG8_BAR; PG8_MMA(0, 0, At, B0); PG8_MMA(0, 1, At, B1); PG8_BAR; PG8_SCHED;
            PG8_LDA(At, 1, 1); PG8_STAGE(PG8_SB(1, 0), b3, voffB); PG8_STAGE(PG8_SB(1, 1), b3 + hstep, voffB); PG8_STAGE(PG8_SA(1, 0), a3, voffA);
            PG8_WAIT_V(8); PG8_WAIT_L(0); PG8_BAR; PG8_MMA(1, 0, At, B0); PG8_MMA(1, 1, At, B1); PG8_BAR; PG8_SCHED;
            } else {
            PG8_LDB(B0, 0, 0); PG8_SCHED; PG8_LDA(At, 0, 0); PG8_STAGE(PG8_SA(1, 1), a1 + hstep, voffA);
            PG8_WAIT_L(8); PG8_BAR; PG8_WAIT_L(0); PG8_MMA(0, 0, At, B0); PG8_BAR; PG8_SCHED;
            PG8_LDB(B1, 0, 1); PG8_STAGE(PG8_SB(0, 0), b2, voffB);
            PG8_BAR; PG8_WAIT_L(0); PG8_MMA(0, 1, At, B1); PG8_BAR;
            PG8_LDA(At, 0, 1); PG8_STAGE(PG8_SA(0, 0), a2, voffA);
            PG8_BAR; PG8_WAIT_L(0); PG8_MMA(1, 0, At, B0); PG8_BAR; PG8_SCHED;
            PG8_STAGE(PG8_SB(0, 1), b2 + hstep, voffB);
            PG8_WAIT_V(6); PG8_BAR; PG8_MMA(1, 1, At, B1); PG8_BAR;
            PG8_LDB(B0, 1, 0); PG8_SCHED; PG8_LDA(At, 1, 0); PG8_STAGE(PG8_SA(0, 1), a2 + hstep, voffA);
            PG8_WAIT_L(8); PG8_BAR; PG8_WAIT_L(0); PG8_MMA(0, 0, At, B0); PG8_BAR; PG8_SCHED;
            PG8_LDB(B1, 1, 1); PG8_STAGE(PG8_SB(1, 0), b3, voffB);
            PG8_BAR; PG8_WAIT_L(0); PG8_MMA(0, 1, At, B1); PG8_BAR;
            PG8_LDA(At, 1, 1); PG8_STAGE(PG8_SA(1, 0), a3, voffA);
            PG8_BAR; PG8_WAIT_L(0); PG8_MMA(1, 0, At, B0); PG8_BAR; PG8_SCHED;
            PG8_STAGE(PG8_SB(1, 1), b3 + hstep, voffB);
            PG8_WAIT_V(6); PG8_BAR; PG8_MMA(1, 1, At, B1); PG8_BAR;
            }
        }
        if constexpr (ALIGN_EPI) { if (wr == 0) PG8_BAR; }
        if constexpr (!Epi::AFTER_DRAIN) { E(acc, cur, wr, wc, fr, fq); S.done(cur); }
        if (!has_next) break;
#pragma unroll
        for (int a = 0; a < 2; ++a)
#pragma unroll
            for (int b = 0; b < 2; ++b)
#pragma unroll
                for (int m = 0; m < 4; ++m)
#pragma unroll
                    for (int n = 0; n < 2; ++n) acc[a][b][m][n] = (f32x4){0.f, 0.f, 0.f, 0.f};
        cur = nxt; cA = nA; cB = nB; ++ui;
        if constexpr (ALIGN_EPI) { if (wr == 1) PG8_BAR; }
    }
    PG8_WAIT_V(0);
    if constexpr (!ALIGN_EPI) { if (wr == 0) PG8_BAR; }
    PG8_BAR;
    if constexpr (Epi::AFTER_DRAIN) { E.fused(acc, cur, wr, wc, fr, fq, lds, wid, lane); S.done(cur); }
#undef PG8_SA
#undef PG8_SB
#undef PG8_STAGE
#undef PG8_LDA
#undef PG8_LDB
#undef PG8_MMA
#undef PG8_WAIT_V
#undef PG8_WAIT_L
#undef PG8_BAR
#undef PG8_SCHED
}
}

#define LAS __attribute__((address_space(3)))
typedef unsigned short bf16;
typedef short bf16x8 __attribute__((ext_vector_type(8)));
typedef short s16x4 __attribute__((ext_vector_type(4)));
typedef float f32x4 __attribute__((ext_vector_type(4)));
typedef float f32x16 __attribute__((ext_vector_type(16)));
typedef unsigned u32x4 __attribute__((ext_vector_type(4)));
typedef unsigned u32x2 __attribute__((ext_vector_type(2)));

constexpr int BATCH = 8, SEQ = 2048, DM = 1024, MROWS = BATCH * SEQ;
constexpr int AW = 768, DFF = 2816, NUP = 2 * DFF, NLAYER = 4;
constexpr float RMS_EPS = 1e-6f;
constexpr float LOG2E = 1.4426950408889634f;
constexpr float QSCALE = 0.125f * 1.4426950408889634f;
constexpr size_t MiB = 1u << 20;
constexpr size_t WS_ROPE = 64 * 1024;
constexpr size_t WS_WFT = 256 * 1024;
constexpr size_t WS_W = 1 * MiB;
constexpr size_t W_QK_A = WS_W, W_V_A = WS_W + 6 * MiB, W_O_A = WS_W + 9 * MiB, W_QK_B = WS_W + 12 * MiB, W_V_B = WS_W + 16 * MiB,
                 W_Q_B1 = WS_W + 18 * MiB, W_O_B = WS_W + 20 * MiB, W_UP = WS_W + 24 * MiB, W_DN = WS_W + 68 * MiB;
constexpr size_t WS_C2 = 91 * MiB, WS_FLOG = 92 * MiB, WS_LSE = 93 * MiB;
constexpr size_t WS_XN = 94 * MiB;
constexpr size_t WS_F = 126 * MiB;
constexpr size_t WS_G = 190 * MiB;
constexpr size_t G_QK_A = WS_G, G_VT_A = WS_G + 48 * MiB, G_O_A = WS_G + 72 * MiB, G_XP1 = WS_G + 96 * MiB, G_XP2 = WS_G + 128 * MiB;
constexpr size_t G_Q_B = WS_G, G_O_B = WS_G + 32 * MiB, G_K_B = WS_G + 96 * MiB, G_VT_B = WS_G + 128 * MiB;
constexpr size_t G_U = WS_G;
constexpr size_t WS_END = 352 * MiB;
constexpr int LDS_BYTES = 147456;
constexpr int NPHASE = 1 + 9 * NLAYER;

__device__ __forceinline__ unsigned pk2(float lo, float hi) {
    typedef float f2 __attribute__((ext_vector_type(2))); typedef __bf16 b2 __attribute__((ext_vector_type(2)));
    f2 v = {lo, hi}; b2 b = __builtin_convertvector(v, b2); return __builtin_bit_cast(unsigned, b);
}
__device__ __forceinline__ float bf_lo(unsigned w) { return __uint_as_float(w << 16); }
__device__ __forceinline__ float bf_hi(unsigned w) { return __uint_as_float(w & 0xffff0000u); }
__device__ __forceinline__ float wave_sum(float v) {
#pragma unroll
    for (int o = 1; o < 64; o <<= 1) v += __shfl_xor(v, o);
    return v;
}
#define LDS_WAIT() asm volatile("s_waitcnt lgkmcnt(0)" ::: "memory")

namespace pg8 {
struct EpiF32 {
    static constexpr bool PERM = false, AFTER_DRAIN = false;
    float* O; int ldc;
    __device__ __forceinline__ void operator()(const f32x4 (&acc)[2][2][4][2], const Unit& u, int wr, int wc, int fr, int fq) const {
        const int row0 = u.pm * BM + wr * 64 + fr, col0 = u.pn * BM + wc * 32 + 4 * fq;
#pragma unroll
        for (int ai = 0; ai < 2; ++ai)
#pragma unroll
            for (int m = 0; m < 4; ++m) { float* rowp = O + (size_t)(row0 + ai * HALF + m * 16) * ldc + col0;
#pragma unroll
                for (int bj = 0; bj < 2; ++bj)
#pragma unroll
                    for (int n = 0; n < 2; ++n) *(f32x4*)(rowp + bj * HALF + n * 16) = acc[ai][bj][m][n]; }
    }
};
template <int CTRL> __device__ __forceinline__ float dppf(float old, float src) {
    return __int_as_float(__builtin_amdgcn_update_dpp(__float_as_int(old), __float_as_int(src), CTRL, 0xf, 0xf, false));
}
__device__ __forceinline__ float gelu_tanh(float x) {
    const float z = 0.7978845608028654f * (x + 0.044715f * x * x * x);
    const float e = __builtin_amdgcn_exp2f(-2.0f * 1.4426950408889634f * z);
    return x * __builtin_amdgcn_rcpf(1.0f + e);
}
struct EpiConvGlu {
    static constexpr bool PERM = true, AFTER_DRAIN = false;
    bf16_t* U; float* side; const float* cw; const float* cb;
    __device__ __forceinline__ void operator()(const f32x4 (&acc)[2][2][4][2], const Unit& u, int wr, int wc, int fr, int fq) const {
        const int chb = u.pn * HALF + wc * 32 + 8 * fq;
#pragma unroll
        for (int n = 0; n < 2; ++n) {
            const int ch = chb + 4 * n;
            const f32x4 wg0 = *(const f32x4*)(cw + ch), wg1 = *(const f32x4*)(cw + NUP + ch), wg2 = *(const f32x4*)(cw + 2 * NUP + ch), bg = *(const f32x4*)(cb + ch);
            const f32x4 wv0 = *(const f32x4*)(cw + DFF + ch), wv1 = *(const f32x4*)(cw + NUP + DFF + ch), wv2 = *(const f32x4*)(cw + 2 * NUP + DFF + ch), bv = *(const f32x4*)(cb + DFF + ch);
#pragma unroll
            for (int ai = 0; ai < 2; ++ai) {
                const int chunk = u.pm * 4 + ai * 2 + wr, rowbase = u.pm * BM + ai * HALF + wr * 64;
#pragma unroll
                for (int m = 0; m < 4; ++m) {
                    const f32x4 xg = acc[ai][0][m][n], xv = acc[ai][1][m][n];
                    if (m == 0 && fr < 2) { float* sp = side + (size_t)(chunk * 4 + fr) * NUP + ch; *(f32x4*)sp = xg; *(f32x4*)(sp + DFF) = xv; }
                    if (m == 3 && fr >= 14) { float* sp = side + (size_t)(chunk * 4 + fr - 12) * NUP + ch; *(f32x4*)sp = xg; *(f32x4*)(sp + DFF) = xv; }
                    f32x4 pg = (f32x4){0.f, 0.f, 0.f, 0.f}, pv = pg;
                    if (m > 0) { pg = acc[ai][0][m - 1][n]; pv = acc[ai][1][m - 1][n]; }
                    f32x4 g1, g2, v1, v2;
#pragma unroll
                    for (int e = 0; e < 4; ++e) {
                        g1[e] = dppf<0x111>(dppf<0x121>(0.f, pg[e]), xg[e]); g2[e] = dppf<0x112>(dppf<0x122>(0.f, pg[e]), xg[e]);
                        v1[e] = dppf<0x111>(dppf<0x121>(0.f, pv[e]), xv[e]); v2[e] = dppf<0x112>(dppf<0x122>(0.f, pv[e]), xv[e]);
                    }
                    const f32x4 cg = wg0 * g2 + wg1 * g1 + wg2 * xg + bg, cv = wv0 * v2 + wv1 * v1 + wv2 * xv + bv;
                    f32x4 o;
#pragma unroll
                    for (int e = 0; e < 4; ++e) o[e] = gelu_tanh(cg[e]) * cv[e];
                    if (!(m == 0 && fr < 2)) { u32x2 w; w.x = pk2(o[0], o[1]); w.y = pk2(o[2], o[3]); *(u32x2*)(U + (size_t)(rowbase + m * 16 + fr) * DFF + ch) = w; }
                }
            }
        }
    }
};
}

__device__ __forceinline__ void wt_item(const float* W, int ldw, int K, int k0, int ncol0, bf16* WT, int out_row0, const float* gain, float scale, LAS float* scr, int lane) {
#pragma unroll 8
    for (int i = 0; i < 32; ++i) { const int kk = 2 * i + (lane >> 5); const float g = gain ? gain[k0 + kk] * scale : scale;
        scr[kk * 33 + (lane & 31)] = W[(size_t)(k0 + kk) * ldw + ncol0 + (lane & 31)] * g; }
    LDS_WAIT();
    const int c = lane & 7;
#pragma unroll
    for (int j = 0; j < 4; ++j) { const int n = (lane >> 3) + 8 * j; const LAS float* s = scr + (8 * c) * 33 + n;
        u32x4 o; o.x = pk2(s[0 * 33], s[1 * 33]); o.y = pk2(s[2 * 33], s[3 * 33]); o.z = pk2(s[4 * 33], s[5 * 33]); o.w = pk2(s[6 * 33], s[7 * 33]);
        *(u32x4*)(WT + (size_t)(out_row0 + n) * K + k0 + 8 * c) = o; }
    LDS_WAIT();
}
__device__ __forceinline__ void conv_mat(const float* W, int ldw, int K, int col0, int ncols, bf16* WT, int mode, const float* gain, float scale,
                                         LAS float* scr, int gw, int NGW, int lane, int& off) {
    const int nnb = ncols / 32, nitems = (K / 64) * nnb;
    for (int it = (gw + NGW - off) % NGW; it < nitems; it += NGW) {
        const int kb = it / nnb, nb = it % nnb, n0 = 32 * nb;
        int out_row0 = n0;
        if (mode == 1) { const int bj = n0 / DFF, ch0 = n0 % DFF; out_row0 = 256 * (ch0 / 128) + 128 * bj + (ch0 % 128); }
        wt_item(W, ldw, K, 64 * kb, col0 + n0, WT, out_row0, gain, scale, scr, lane);
    }
    off = (off + nitems) % NGW;
}

__device__ __forceinline__ void sincos_f64(float ang, float& sn, float& cs) {
    const double x = (double)ang; const double k = __builtin_rint(x * 0.63661977236758134308);
    double r = __builtin_fma(-k, 1.57079632679489655800, x); r = __builtin_fma(-k, 6.12323399573676603587e-17, r);
    const double r2 = r * r;
    double s = 1.6059043836821613e-10; s = s * r2 - 2.5052108385441720e-08; s = s * r2 + 2.7557319223985893e-06; s = s * r2 - 1.9841269841269841e-04;
    s = s * r2 + 8.3333333333333332e-03; s = s * r2 - 1.6666666666666666e-01; s = s * r2 * r + r;
    double c = -1.1470745597729725e-11; c = c * r2 + 2.0876756987868100e-09; c = c * r2 - 2.7557319223985888e-07; c = c * r2 + 2.4801587301587302e-05;
    c = c * r2 - 1.3888888888888889e-03; c = c * r2 + 4.1666666666666664e-02; c = c * r2 - 0.5; c = c * r2 + 1.0;
    const int q = ((int)k) & 3;
    const double ss = (q == 0) ? s : (q == 1) ? c : (q == 2) ? -s : -c;
    const double cc = (q == 0) ? c : (q == 1) ? -s : (q == 2) ? -c : s;
    sn = (float)ss; cs = (float)cc;
}

template <int MODE>
__device__ __forceinline__ void row_phase(const float* src, const float* gain, float* h, bf16* xn, bf16* xp1, bf16* xp2, bool want_xn, bool want_perm,
                                          bool want_forget, const LAS float* wft, const float* bfg, float* flog, int gw, int NGW, int lane) {
    for (int m = gw; m < MROWS; m += NGW) {
        f32x4 v[4]; float ss = 0.f;
#pragma unroll
        for (int j = 0; j < 4; ++j) { v[j] = *(const f32x4*)(src + (size_t)m * DM + 4 * lane + 256 * j); ss += (v[j].x * v[j].x + v[j].y * v[j].y) + (v[j].z * v[j].z + v[j].w * v[j].w); }
        if (MODE == 1) {
            const float rs = 1.0f / sqrtf(wave_sum(ss) * (1.0f / DM) + RMS_EPS); ss = 0.f;
#pragma unroll
            for (int j = 0; j < 4; ++j) { const f32x4 g = *(const f32x4*)(gain + 4 * lane + 256 * j); const f32x4 ho = *(const f32x4*)(h + (size_t)m * DM + 4 * lane + 256 * j);
                v[j] = ho + v[j] * rs * g; ss += (v[j].x * v[j].x + v[j].y * v[j].y) + (v[j].z * v[j].z + v[j].w * v[j].w); }
        }
#pragma unroll
        for (int j = 0; j < 4; ++j) *(f32x4*)(h + (size_t)m * DM + 4 * lane + 256 * j) = v[j];
        if (want_xn) {
            const float rs2 = 1.0f / sqrtf(wave_sum(ss) * (1.0f / DM) + RMS_EPS);
#pragma unroll
            for (int j = 0; j < 4; ++j) v[j] = v[j] * rs2;
            u32x2 w[4];
#pragma unroll
            for (int j = 0; j < 4; ++j) { w[j].x = pk2(v[j].x, v[j].y); w[j].y = pk2(v[j].z, v[j].w); *(u32x2*)(xn + (size_t)m * DM + 4 * lane + 256 * j) = w[j]; }
            if (want_perm) {
                const int b = m / SEQ, t = m % SEQ;
                const size_t m1 = (size_t)b * SEQ + (t & 3) * 512 + (t >> 2), m2 = (size_t)b * SEQ + (t & 15) * 128 + (t >> 4);
#pragma unroll
                for (int j = 0; j < 4; ++j) { *(u32x2*)(xp1 + m1 * DM + 4 * lane + 256 * j) = w[j]; *(u32x2*)(xp2 + m2 * DM + 4 * lane + 256 * j) = w[j]; }
            }
            if (want_forget) {
                float mine = 0.f;
#pragma unroll 4
                for (int hd = 0; hd < 16; ++hd) { float a = 0.f;
#pragma unroll
                    for (int j = 0; j < 4; ++j) { const f32x4 wv = *(const LAS f32x4*)(wft + hd * DM + 4 * lane + 256 * j); a += (v[j].x * wv.x + v[j].y * wv.y) + (v[j].z * wv.z + v[j].w * wv.w); }
                    a = wave_sum(a); if (lane == hd) mine = a; }
                if (lane < 16) flog[(size_t)m * 16 + lane] = mine + bfg[lane];
            }
        }
    }
}

__device__ __forceinline__ float log_sigmoid(float x) { return fminf(x, 0.f) - logf(1.0f + expf(-fabsf(x))); }
__device__ __forceinline__ void scan_unit(const float* flog, float* c2, int bh, int lane) {
    const int b = bh >> 4, hd = bh & 15; const float* fp = flog + ((size_t)b * SEQ + 32 * lane) * 16 + hd;
    float tot = 0.f;
    for (int i = 0; i < 32; ++i) tot += log_sigmoid(fp[i * 16]);
    float inc = tot;
#pragma unroll
    for (int o = 1; o < 64; o <<= 1) { const float t = __shfl_up(inc, o); if (lane >= o) inc += t; }
    float run = inc - tot;
    float* cp = c2 + (size_t)bh * SEQ + 32 * lane;
    for (int i = 0; i < 32; ++i) { run += log_sigmoid(fp[i * 16]); cp[i] = run * LOG2E; }
}

struct AttnHalf {
    const bf16* Q; const bf16* K; const bf16* VT; bf16* O; float* lse; const float* cq;
    int q_stride, k_stride, vt_pitch, o_stride, lse_stride;
    int q0, kv_begin, nback, pos0, pos_step;
};
constexpr int AT_PITCH = 144, AT_K = 0, AT_V = 9216, AT_CK = 18432, AT_BUF = 18688, AT_HALF = 2 * AT_BUF;
__device__ __forceinline__ int crow(int r, int hi) { return (r & 3) + 8 * (r >> 2) + 4 * hi; }
__device__ __forceinline__ void rope16(u32x4& a, u32x4& b, const float* ct, const float* st) {
    const f32x4 c0 = *(const f32x4*)ct, c1 = *(const f32x4*)(ct + 4), s0 = *(const f32x4*)st, s1 = *(const f32x4*)(st + 4);
#define RC_(k) ((k) < 4 ? c0[(k) & 3] : c1[(k) & 3])
#define RS_(k) ((k) < 4 ? s0[(k) & 3] : s1[(k) & 3])
    u32x4 oa, ob;
#pragma unroll
    for (int i = 0; i < 4; ++i) {
        const float x1l = bf_lo(a[i]), x1h = bf_hi(a[i]), x2l = bf_lo(b[i]), x2h = bf_hi(b[i]);
        oa[i] = pk2(x1l * RC_(2 * i) - x2l * RS_(2 * i), x1h * RC_(2 * i + 1) - x2h * RS_(2 * i + 1));
        ob[i] = pk2(x2l * RC_(2 * i) + x1l * RS_(2 * i), x2h * RC_(2 * i + 1) + x1h * RS_(2 * i + 1));
    }
    a = oa; b = ob;
#undef RC_
#undef RS_
}

template <int QB, bool ROPE, bool BIAS>
__device__ __forceinline__ void attn_super(const AttnHalf& U, int ntiles, LAS unsigned char* ldsbase, const float* ropetab, int tid) {
    const int lane = tid & 63, r32 = lane & 31, hi = lane >> 5, tidh = tid & 255, waveh = (tid >> 6) & 3, half = tid >> 8;
    LAS unsigned char* lds = ldsbase + half * AT_HALF;
    const int qlo = U.q0 + waveh * 32 * QB, qhi = qlo + 32 * QB - 1;
    bf16x8 qf[QB][4]; float cqv[QB];
#pragma unroll
    for (int qb = 0; qb < QB; ++qb) {
        const int qi = qlo + 32 * qb + r32; const bf16* src = U.Q + (size_t)qi * U.q_stride;
#pragma unroll
        for (int d0 = 0; d0 < 4; ++d0) qf[qb][d0] = *(const bf16x8*)(src + 16 * d0 + 8 * hi);
        if (ROPE) { u32x4 a = *(const u32x4*)src, b = *(const u32x4*)(src + 8); const int pos = U.pos0 + qi * U.pos_step;
            rope16(a, b, ropetab + pos * 8, ropetab + SEQ * 8 + pos * 8); qf[qb][0] = __builtin_bit_cast(bf16x8, hi ? b : a); }
        cqv[qb] = BIAS ? U.cq[qi] : 0.f;
    }
    f32x16 OT[QB][2]; float mrun[QB], lrun[QB];
#pragma unroll
    for (int qb = 0; qb < QB; ++qb) { mrun[qb] = -1e30f; lrun[qb] = 0.f;
#pragma unroll
        for (int dh = 0; dh < 2; ++dh)
#pragma unroll
            for (int r = 0; r < 16; ++r) OT[qb][dh][r] = 0.f; }
    u32x4 kr0, kr1, vr0, vr1; f32x4 ckr = (f32x4){0.f, 0.f, 0.f, 0.f};
    const int trow = tidh >> 2, tseg = tidh & 3;
#define AT_LOAD(t) do { const int kv0_ = U.kv_begin + 64 * (t); const int kvc_ = kv0_ < 0 ? 0 : kv0_; \
        const bf16* ks_ = U.K + (size_t)(kvc_ + trow) * U.k_stride + 16 * tseg; kr0 = *(const u32x4*)ks_; kr1 = *(const u32x4*)(ks_ + 8); \
        const bf16* vs_ = U.VT + (size_t)trow * U.vt_pitch + kvc_ + 16 * tseg; vr0 = *(const u32x4*)vs_; vr1 = *(const u32x4*)(vs_ + 8); \
        if (BIAS) { if (tidh < 16) ckr = *(const f32x4*)(U.cq + kvc_ + 4 * tidh); } \
        if (ROPE) { if (tseg == 0) { const int pos_ = U.pos0 + (kvc_ + trow) * U.pos_step; rope16(kr0, kr1, ropetab + pos_ * 8, ropetab + SEQ * 8 + pos_ * 8); } } } while (0)
#define AT_STORE(buf) do { LAS unsigned char* b_ = lds + (buf) * AT_BUF; \
        *(LAS u32x4*)(b_ + AT_K + trow * AT_PITCH + tseg * 32) = kr0; *(LAS u32x4*)(b_ + AT_K + trow * AT_PITCH + tseg * 32 + 16) = kr1; \
        *(LAS u32x4*)(b_ + AT_V + trow * AT_PITCH + tseg * 32) = vr0; *(LAS u32x4*)(b_ + AT_V + trow * AT_PITCH + tseg * 32 + 16) = vr1; \
        if (BIAS) { if (tidh < 16) *(LAS f32x4*)(b_ + AT_CK + 16 * tidh) = ckr; } } while (0)
    AT_LOAD(0); AT_STORE(0);
    __syncthreads();
    for (int t = 0; t < ntiles; ++t) {
        if (t + 1 < ntiles) AT_LOAD(t + 1);
        const LAS unsigned char* bb = lds + (t & 1) * AT_BUF;
        const int kv0 = U.kv_begin + 64 * t;
#pragma unroll
        for (int kb = 0; kb < 2; ++kb) {
            const int kvb = kv0 + 32 * kb;
            if (kvb < 0 || kvb > qhi || qlo - (kvb + 31) > U.nback) continue;
            bf16x8 kf[4];
#pragma unroll
            for (int d0 = 0; d0 < 4; ++d0) kf[d0] = *(const LAS bf16x8*)(bb + AT_K + (32 * kb + r32) * AT_PITCH + (16 * d0 + 8 * hi) * 2);
            f32x4 ck4[4];
            if (BIAS) {
#pragma unroll
                for (int jj = 0; jj < 4; ++jj) ck4[jj] = *(const LAS f32x4*)(bb + AT_CK + (32 * kb + 8 * jj + 4 * hi) * 4);
            }
            bf16x8 pa[QB][2];
#pragma unroll
            for (int qb = 0; qb < QB; ++qb) {
                f32x16 S;
#pragma unroll
                for (int r = 0; r < 16; ++r) S[r] = 0.f;
#pragma unroll
                for (int d0 = 0; d0 < 4; ++d0) S = __builtin_amdgcn_mfma_f32_32x32x16_bf16(kf[d0], qf[qb][d0], S, 0, 0, 0);
                const int qb0 = qlo + 32 * qb, qi = qb0 + r32;
                if (BIAS) {
#pragma unroll
                    for (int r = 0; r < 16; ++r) S[r] += cqv[qb] - ck4[r >> 2][r & 3];
                }
                if (kvb + 31 > qb0 || qb0 + 31 - kvb > U.nback) {
#pragma unroll
                    for (int r = 0; r < 16; ++r) { const int kvj = kvb + crow(r, hi); const bool ok = (kvj <= qi) && (qi - kvj <= U.nback); S[r] = ok ? S[r] : -INFINITY; }
                }
                float mx = S[0];
#pragma unroll
                for (int r = 1; r < 16; ++r) mx = fmaxf(mx, S[r]);
                mx = fmaxf(mx, __shfl_xor(mx, 32));
                const float mnew = fmaxf(mrun[qb], mx);
                const float alpha = __builtin_amdgcn_exp2f(mrun[qb] - mnew);
                if (__any(mnew > mrun[qb])) {
#pragma unroll
                    for (int dh = 0; dh < 2; ++dh)
#pragma unroll
                        for (int r = 0; r < 16; ++r) OT[qb][dh][r] *= alpha;
                }
                mrun[qb] = mnew;
                float ps = 0.f;
#pragma unroll
                for (int r = 0; r < 16; ++r) { S[r] = __builtin_amdgcn_exp2f(S[r] - mnew); ps += S[r]; }
                lrun[qb] = lrun[qb] * alpha + ps;
#pragma unroll
                for (int ks = 0; ks < 2; ++ks) { u32x4 w; w.x = pk2(S[8 * ks], S[8 * ks + 1]); w.y = pk2(S[8 * ks + 2], S[8 * ks + 3]); w.z = pk2(S[8 * ks + 4], S[8 * ks + 5]); w.w = pk2(S[8 * ks + 6], S[8 * ks + 7]);
                    pa[qb][ks] = __builtin_bit_cast(bf16x8, w); }
            }
#pragma unroll
            for (int ks = 0; ks < 2; ++ks)
#pragma unroll
                for (int dh = 0; dh < 2; ++dh) {
                    const LAS unsigned char* vp = bb + AT_V + (32 * dh + r32) * AT_PITCH + (32 * kb + 16 * ks + 4 * hi) * 2;
                    const s16x4 lo = *(const LAS s16x4*)vp, hi4 = *(const LAS s16x4*)(vp + 16);
                    const bf16x8 vf = (bf16x8){lo[0], lo[1], lo[2], lo[3], hi4[0], hi4[1], hi4[2], hi4[3]};
#pragma unroll
                    for (int qb = 0; qb < QB; ++qb) OT[qb][dh] = __builtin_amdgcn_mfma_f32_32x32x16_bf16(vf, pa[qb][ks], OT[qb][dh], 0, 0, 0);
                }
        }
        if (t + 1 < ntiles) AT_STORE((t + 1) & 1);
        __syncthreads();
    }
#undef AT_LOAD
#undef AT_STORE
#pragma unroll
    for (int qb = 0; qb < QB; ++qb) {
        const float l = lrun[qb] + __shfl_xor(lrun[qb], 32); const float inv = 1.0f / l;
        const int qi = qlo + 32 * qb + r32; bf16* op = U.O + (size_t)qi * U.o_stride;
#pragma unroll
        for (int dh = 0; dh < 2; ++dh)
#pragma unroll
            for (int r4 = 0; r4 < 4; ++r4) { u32x2 w; w.x = pk2(OT[qb][dh][4 * r4] * inv, OT[qb][dh][4 * r4 + 1] * inv); w.y = pk2(OT[qb][dh][4 * r4 + 2] * inv, OT[qb][dh][4 * r4 + 3] * inv);
                *(u32x2*)(op + 32 * dh + 8 * r4 + 4 * hi) = w; }
        if (U.lse && hi == 0) U.lse[(size_t)qi * U.lse_stride] = mrun[qb] + __builtin_amdgcn_logf(l);
    }
}

struct Args { const float* in[13]; float* out; unsigned char* ws; float invf[8]; int ph_lo, ph_hi; };
enum { IN_X = 0, IN_GAINS, IN_WQKV_A, IN_WO_A, IN_WQ_B, IN_WO_B, IN_KVNORM, IN_WKVF, IN_BF, IN_WUP, IN_CONVW, IN_CONVB, IN_WDOWN };

__host__ __device__ inline bool phase_noop(int ph) { if (ph == 0) return false; const int l = (ph - 1) / 9, s = (ph - 1) % 9; return (s == 2 && l >= 2); }

#define PH_LOCALS() \
    int tid = threadIdx.x; asm volatile("" : "+v"(tid)); \
    const int lane = tid & 63, wave = __builtin_amdgcn_readfirstlane(tid >> 6); \
    const int G = gridDim.x, bx = blockIdx.x, gw = bx * 8 + wave, NGW = G * 8; \
    unsigned char* ws = a.ws; float* h = a.out; \
    bf16* xn = (bf16*)(ws + WS_XN); float* Fb = (float*)(ws + WS_F); \
    const float* gains = a.in[IN_GAINS]; const float* ropetab = (const float*)(ws + WS_ROPE); \
    (void)lane; (void)wave; (void)gw; (void)NGW; (void)h; (void)xn; (void)Fb; (void)gains; (void)ropetab; (void)G; (void)bx
#define PH_BEGIN(k) if (a.ph_lo <= (k) && (k) < a.ph_hi) { PH_LOCALS();
#define PH_END(k) if ((k) + 1 < a.ph_hi) grid.sync(); }

template <int L>
__device__ __forceinline__ void run_layer(const Args& a, LAS unsigned char* lds, cg::grid_group& grid) {
    constexpr int base = 1 + 9 * L; constexpr bool isA = L < 2; constexpr int l = L;
    PH_BEGIN(base + 0)
        if (L == 2) { if (gw < BATCH * 16) scan_unit((const float*)(ws + WS_FLOG), (float*)(ws + WS_C2), gw, lane); }
        constexpr int njobs = isA ? 4 : (L == 2 ? 2 : 1);
        for (int j = 0; j < njobs; ++j) {
            pg8::Gemm g; bf16* O; int ldc, split = 0, rot = 0; size_t sstride = 0;
            if (isA) {
                if (j == 0) { g = pg8::Gemm{xn, (const bf16*)(ws + W_QK_A + l * 3 * MiB), MROWS, 1536, DM}; O = (bf16*)(ws + G_QK_A); ldc = 1536; }
                else { const bf16* Bt = (j == 1) ? xn : (j == 2) ? (const bf16*)(ws + G_XP1) : (const bf16*)(ws + G_XP2);
                    g = pg8::Gemm{(const bf16*)(ws + W_V_A + l * 3 * MiB / 2) + (size_t)(j - 1) * 256 * DM, Bt, 256, MROWS, DM};
                    O = (bf16*)(ws + G_VT_A) + (size_t)(j - 1) * 256 * MROWS; ldc = MROWS; rot = (j == 1) ? 128 : (j == 2) ? 64 : 0; }
            } else if (L == 2) {
                if (j == 0) { g = pg8::Gemm{xn, (const bf16*)(ws + W_QK_B), MROWS, 2048, DM}; O = (bf16*)(ws + G_Q_B); ldc = DM; split = DM; sstride = (G_K_B - G_Q_B) / 2; }
                else { g = pg8::Gemm{(const bf16*)(ws + W_V_B), xn, DM, MROWS, DM}; O = (bf16*)(ws + G_VT_B); ldc = MROWS; }
            } else { g = pg8::Gemm{xn, (const bf16*)(ws + W_Q_B1), MROWS, DM, DM}; O = (bf16*)(ws + G_Q_B); ldc = DM; }
            pg8::StaticOrder S; S.init(g.M, g.N, G, (bx + rot) % G);
            pg8::EpiBf16<0> E{O, ldc, nullptr, split, sstride, 1.f};
            pg8::gemm_phase<pg8::EpiBf16<0>, pg8::StaticOrder, true, true>(lds, g, S, E);
            __syncthreads();
        }
    PH_END(base + 0)
    PH_BEGIN(base + 1)
        if (isA) {
            for (int su = bx; su < 768; su += G) {
                const int grp = su >> 8, hu = 2 * (su & 255) + (tid >> 8);
                const int r = (grp == 0) ? 1 : (grp == 1) ? 4 : 16, Lq = SEQ / r, nqb = Lq / 128;
                const int j = hu & 3, qb = (hu >> 2) % nqb, sq = (hu >> 2) / nqb, b = sq / r, rho = sq % r, hd12 = grp * 4 + j;
                AttnHalf U;
                const size_t row0 = (size_t)b * SEQ + rho;
                U.Q = (const bf16*)(ws + G_QK_A) + row0 * 1536 + hd12 * 64; U.K = U.Q + 768; U.q_stride = r * 1536; U.k_stride = r * 1536;
                U.VT = (const bf16*)(ws + G_VT_A) + (size_t)(grp * 256 + j * 64) * MROWS + (size_t)b * SEQ + (size_t)rho * Lq; U.vt_pitch = MROWS;
                U.O = (bf16*)(ws + G_O_A) + row0 * AW + hd12 * 64; U.o_stride = r * AW;
                U.lse = (float*)(ws + WS_LSE) + row0 * 12 + hd12; U.lse_stride = r * 12; U.cq = nullptr;
                U.q0 = qb * 128; U.kv_begin = U.q0 - 128; U.nback = 128; U.pos0 = rho; U.pos_step = r;
                attn_super<1, true, false>(U, 4, lds, ropetab, tid);
            }
        } else {
            for (int i = 0; i < 4; ++i) {
                for (int w = bx; w < 256; w += G) {
                    const int pair = w >> 2, sx = w & 3, qb = (i == 0) ? sx : (i == 1) ? 15 - sx : (i == 2) ? 4 + sx : 11 - sx;
                    const int b = pair >> 3, hd = 2 * (pair & 7) + (tid >> 8);
                    AttnHalf U;
                    U.Q = (const bf16*)(ws + G_Q_B) + (size_t)b * SEQ * DM + hd * 64; U.K = (const bf16*)(ws + G_K_B) + (size_t)b * SEQ * DM + hd * 64; U.q_stride = DM; U.k_stride = DM;
                    U.VT = (const bf16*)(ws + G_VT_B) + (size_t)(hd * 64) * MROWS + (size_t)b * SEQ; U.vt_pitch = MROWS;
                    U.O = (bf16*)(ws + G_O_B) + (size_t)b * SEQ * DM + hd * 64; U.o_stride = DM; U.lse = nullptr; U.lse_stride = 0;
                    U.cq = (const float*)(ws + WS_C2) + (size_t)(b * 16 + hd) * SEQ;
                    U.q0 = qb * 128; U.kv_begin = 0; U.nback = 1 << 30; U.pos0 = 0; U.pos_step = 0;
                    attn_super<1, false, true>(U, 2 * (qb + 1), lds, ropetab, tid);
                }
            }
        }
    PH_END(base + 1)
    if (isA) {
    PH_BEGIN(base + 2)
        const float* lse = (const float*)(ws + WS_LSE); bf16* o = (bf16*)(ws + G_O_A);
        for (int idx = bx * 512 + tid; idx < MROWS * 96; idx += G * 512) {
            const int m = idx / 96, hd12 = (idx >> 3) % 12, j = hd12 & 3, grp = hd12 >> 2;
            const float l0 = lse[(size_t)m * 12 + j], l1 = lse[(size_t)m * 12 + 4 + j], l2 = lse[(size_t)m * 12 + 8 + j];
            const float mx = fmaxf(l0, fmaxf(l1, l2));
            const float e0 = __builtin_amdgcn_exp2f(l0 - mx), e1 = __builtin_amdgcn_exp2f(l1 - mx), e2 = __builtin_amdgcn_exp2f(l2 - mx);
            const float wgt = ((grp == 0) ? e0 : (grp == 1) ? e1 : e2) / (e0 + e1 + e2);
            u32x4 v = *(const u32x4*)(o + (size_t)idx * 8);
#pragma unroll
            for (int e = 0; e < 4; ++e) v[e] = pk2(bf_lo(v[e]) * wgt, bf_hi(v[e]) * wgt);
            *(u32x4*)(o + (size_t)idx * 8) = v;
        }
    PH_END(base + 2)
    }
    PH_BEGIN(base + 3)
        pg8::Gemm g;
        if (isA) g = pg8::Gemm{(const bf16*)(ws + G_O_A), (const bf16*)(ws + W_O_A + l * 3 * MiB / 2), MROWS, DM, AW};
        else g = pg8::Gemm{(const bf16*)(ws + G_O_B), (const bf16*)(ws + W_O_B + (l - 2) * 2 * MiB), MROWS, DM, DM};
        pg8::StaticOrder S; S.init(g.M, g.N, G, bx);
        pg8::EpiF32 E{Fb, DM};
        pg8::gemm_phase<pg8::EpiF32, pg8::StaticOrder, true, true>(lds, g, S, E);
    PH_END(base + 3)
    PH_BEGIN(base + 4)
        row_phase<1>(Fb, gains + (l * 4 + 1) * DM, h, xn, nullptr, nullptr, true, false, false, (const LAS float*)lds, nullptr, nullptr, gw, NGW, lane);
    PH_END(base + 4)
    PH_BEGIN(base + 5)
        pg8::Gemm g{xn, (const bf16*)(ws + W_UP + l * 11 * MiB), MROWS, NUP, DM};
        pg8::StaticOrder S; S.init(g.M, g.N, G, bx);
        pg8::EpiConvGlu E{(bf16*)(ws + G_U), Fb, a.in[IN_CONVW] + (size_t)l * 3 * NUP, a.in[IN_CONVB] + (size_t)l * NUP};
        pg8::gemm_phase<pg8::EpiConvGlu, pg8::StaticOrder, true, true>(lds, g, S, E);
    PH_END(base + 5)
    PH_BEGIN(base + 6)
        const float* side = Fb; const float* cw = a.in[IN_CONVW] + (size_t)l * 3 * NUP; const float* cb = a.in[IN_CONVB] + (size_t)l * NUP; bf16* Ub = (bf16*)(ws + G_U);
        for (int idx = bx * 512 + tid; idx < 256 * 2 * 704; idx += G * 512) {
            const int cg4 = idx % 704, rr = (idx / 704) & 1, c = idx / 1408, ch = 4 * cg4; const bool first = (c % 32) == 0;
            f32x4 o;
#pragma unroll
            for (int hv = 0; hv < 2; ++hv) {
                const int col = hv * DFF + ch; const f32x4 z = (f32x4){0.f, 0.f, 0.f, 0.f};
                const f32x4 s0 = *(const f32x4*)(side + (size_t)(c * 4 + 0) * NUP + col);
                const f32x4 p3 = first ? z : *(const f32x4*)(side + (size_t)(c * 4 - 1) * NUP + col);
                f32x4 at, at1, at2;
                if (rr == 0) { at = s0; at1 = p3; at2 = first ? z : *(const f32x4*)(side + (size_t)(c * 4 - 2) * NUP + col); }
                else { at = *(const f32x4*)(side + (size_t)(c * 4 + 1) * NUP + col); at1 = s0; at2 = p3; }
                const f32x4 r = *(const f32x4*)(cw + col) * at2 + *(const f32x4*)(cw + NUP + col) * at1 + *(const f32x4*)(cw + 2 * NUP + col) * at + *(const f32x4*)(cb + col);
                if (hv == 0) { o.x = pg8::gelu_tanh(r.x); o.y = pg8::gelu_tanh(r.y); o.z = pg8::gelu_tanh(r.z); o.w = pg8::gelu_tanh(r.w); } else o = o * r;
            }
            u32x2 w; w.x = pk2(o.x, o.y); w.y = pk2(o.z, o.w);
            *(u32x2*)(Ub + (size_t)(c * 64 + rr) * DFF + ch) = w;
        }
    PH_END(base + 6)
    PH_BEGIN(base + 7)
        pg8::Gemm g{(const bf16*)(ws + G_U), (const bf16*)(ws + W_DN + l * 11 * MiB / 2), MROWS, DM, DFF};
        pg8::StaticOrder S; S.init(g.M, g.N, G, bx);
        pg8::EpiF32 E{Fb, DM};
        pg8::gemm_phase<pg8::EpiF32, pg8::StaticOrder, true, true>(lds, g, S, E);
    PH_END(base + 7)
    PH_BEGIN(base + 8)
        constexpr bool last = (L == NLAYER - 1), forget = (L == 1);
        if (forget) { const float* wsrc = (const float*)(ws + WS_WFT); LAS float* wl = (LAS float*)lds;
            for (int i = tid; i < 16 * DM / 4; i += 512) *(LAS f32x4*)(wl + 4 * i) = *(const f32x4*)(wsrc + 4 * i);
            __syncthreads(); }
        row_phase<1>(Fb, gains + (l * 4 + 3) * DM, h, xn, (bf16*)(ws + G_XP1), (bf16*)(ws + G_XP2), !last, L == 0, forget, (const LAS float*)lds, a.in[IN_BF], (float*)(ws + WS_FLOG), gw, NGW, lane);
    PH_END(base + 8)
}

__global__ void __launch_bounds__(512, 2) yoco_fwd(Args a) {
    extern __shared__ __attribute__((aligned(16))) unsigned char lds_raw[];
    LAS unsigned char* lds = (LAS unsigned char*)lds_raw;
    cg::grid_group grid = cg::this_grid();
    PH_BEGIN(0)
        LAS float* scr = (LAS float*)(lds + wave * 16384);
        int off = 0;
        for (int l = 0; l < 2; ++l) {
            const float* g0 = gains + (l * 4 + 0) * DM; const float* W = a.in[IN_WQKV_A] + (size_t)l * DM * 2304;
            conv_mat(W, 2304, DM, 0, 768, (bf16*)(ws + W_QK_A + l * 3 * MiB), 0, g0, QSCALE, scr, gw, NGW, lane, off);
            conv_mat(W, 2304, DM, 768, 768, (bf16*)(ws + W_QK_A + l * 3 * MiB) + (size_t)768 * DM, 0, g0, 1.f, scr, gw, NGW, lane, off);
            conv_mat(W, 2304, DM, 1536, 768, (bf16*)(ws + W_V_A + l * 3 * MiB / 2), 0, g0, 1.f, scr, gw, NGW, lane, off);
            conv_mat(a.in[IN_WO_A] + (size_t)l * AW * DM, DM, AW, 0, DM, (bf16*)(ws + W_O_A + l * 3 * MiB / 2), 0, nullptr, 1.f, scr, gw, NGW, lane, off);
        }
        {
            const float* kvn = a.in[IN_KVNORM];
            conv_mat(a.in[IN_WQ_B], DM, DM, 0, DM, (bf16*)(ws + W_QK_B), 0, gains + (2 * 4 + 0) * DM, QSCALE, scr, gw, NGW, lane, off);
            conv_mat(a.in[IN_WKVF], 2064, DM, 0, DM, (bf16*)(ws + W_QK_B) + (size_t)DM * DM, 0, kvn, 1.f, scr, gw, NGW, lane, off);
            conv_mat(a.in[IN_WKVF], 2064, DM, DM, DM, (bf16*)(ws + W_V_B), 0, kvn, 1.f, scr, gw, NGW, lane, off);
            conv_mat(a.in[IN_WQ_B] + (size_t)DM * DM, DM, DM, 0, DM, (bf16*)(ws + W_Q_B1), 0, gains + (3 * 4 + 0) * DM, QSCALE, scr, gw, NGW, lane, off);
            for (int j = 0; j < 2; ++j) conv_mat(a.in[IN_WO_B] + (size_t)j * DM * DM, DM, DM, 0, DM, (bf16*)(ws + W_O_B + j * 2 * MiB), 0, nullptr, 1.f, scr, gw, NGW, lane, off);
        }
        for (int l = 0; l < NLAYER; ++l) {
            conv_mat(a.in[IN_WUP] + (size_t)l * DM * NUP, NUP, DM, 0, NUP, (bf16*)(ws + W_UP + l * 11 * MiB), 1, gains + (l * 4 + 2) * DM, 1.f, scr, gw, NGW, lane, off);
            conv_mat(a.in[IN_WDOWN] + (size_t)l * DFF * DM, DM, DFF, 0, DM, (bf16*)(ws + W_DN + l * 11 * MiB / 2), 0, nullptr, 1.f, scr, gw, NGW, lane, off);
        }
        const int gt = bx * 512 + tid;
        if (gt < SEQ * 8) { const int pos = gt >> 3, i = gt & 7; float sn, cs; sincos_f64((float)pos * a.invf[i], sn, cs);
            ((float*)(ws + WS_ROPE))[gt] = cs; ((float*)(ws + WS_ROPE))[SEQ * 8 + gt] = sn; }
        if (gt < 16 * DM) { const int hd = gt >> 10, k = gt & 1023; ((float*)(ws + WS_WFT))[gt] = a.in[IN_WKVF][(size_t)k * 2064 + 2048 + hd] * a.in[IN_KVNORM][k]; }
        row_phase<0>(a.in[IN_X], nullptr, h, xn, (bf16*)(ws + G_XP1), (bf16*)(ws + G_XP2), true, true, false, (const LAS float*)lds, nullptr, nullptr, gw, NGW, lane);
    PH_END(0)
    run_layer<0>(a, lds, grid);
    run_layer<1>(a, lds, grid);
    run_layer<2>(a, lds, grid);
    run_layer<3>(a, lds, grid);
}

#ifndef MK_SINGLE
#define MK_SINGLE 1
#endif
extern "C" void kernel_launch(void* const* d_in, const int* in_sizes, int n_in, void* d_out, int out_size, void* d_ws, size_t ws_size, hipStream_t stream) {
    static int grid = 0;
    if (grid == 0) {
        if (n_in != 13 || out_size != MROWS * DM || ws_size < WS_END) { fprintf(stderr, "kernel_launch: unexpected shapes (n_in %d, out %d, ws %zu)\n", n_in, out_size, ws_size); grid = -1; return; }
        int dev = 0, cus = 0, per_cu = 0;
        hipGetDevice(&dev); hipDeviceGetAttribute(&cus, hipDeviceAttributeMultiprocessorCount, dev);
        if (hipFuncSetAttribute((const void*)yoco_fwd, hipFuncAttributeMaxDynamicSharedMemorySize, LDS_BYTES) != hipSuccess) { fprintf(stderr, "kernel_launch: hipFuncSetAttribute failed\n"); grid = -1; return; }
        hipOccupancyMaxActiveBlocksPerMultiprocessor(&per_cu, (const void*)yoco_fwd, 512, LDS_BYTES);
        if (per_cu < 1) { fprintf(stderr, "kernel_launch: occupancy query says %d\n", per_cu); per_cu = 1; }
        (void)hipGetLastError();
        grid = cus * 1;
        fprintf(stderr, "kernel_launch: grid %d (per_cu %d)\n", grid, per_cu);
    }
    if (grid < 0) return;
    Args a{};
    for (int i = 0; i < 13; ++i) a.in[i] = (const float*)d_in[i];
    a.out = (float*)d_out; a.ws = (unsigned char*)d_ws;
    for (int i = 0; i < 8; ++i) a.invf[i] = powf(500000.0f, -(float)(2 * i) / 16.0f);
#if MK_SINGLE
    a.ph_lo = 0; a.ph_hi = NPHASE;
    void* args[] = {&a};
    hipError_t e = hipLaunchCooperativeKernel((const void*)yoco_fwd, dim3(grid), dim3(512), args, LDS_BYTES, stream);
    if (e != hipSuccess) fprintf(stderr, "cooperative launch failed: %s (grid %d)\n", hipGetErrorString(e), grid);
#else
    for (int ph = 0; ph < NPHASE; ++ph) {
        if (phase_noop(ph)) continue;
        a.ph_lo = ph; a.ph_hi = ph + 1;
        hipLaunchKernelGGL(yoco_fwd, dim3(grid), dim3(512), LDS_BYTES, stream, a);
    }
#endif
}
```

```cpp
#include <hip/hip_runtime.h>
#include <hip/hip_cooperative_groups.h>
#include <cstdio>
#include <cstdint>
#include <cmath>
namespace cg = cooperative_groups;
namespace pg8 {
#define PG8_LAS __attribute__((address_space(3)))
typedef unsigned short bf16_t;
typedef short bf16x8 __attribute__((ext_vector_type(8)));
typedef float f32x4 __attribute__((ext_vector_type(4)));
typedef unsigned u32x4 __attribute__((ext_vector_type(4)));
constexpr int BM = 256, BK = 64, HALF = 128, HTB = HALF * BK * 2  , STAGE_BYTES = 8 * HTB, NXCD = 8, WGM = 8;

__host__ __device__ __forceinline__ int lds_byte(int r, int c) { const int st = (r >> 4) * 2 + (c >> 5), rr = r & 15, cc = c & 31, ob = rr * 64 + cc * 2; return st * 1024 + (ob ^ (((ob >> 9) & 1) << 5)); }
__host__ __device__ __forceinline__ void stage_rc(int b, int& R, int& C) { const int st = b / 1024, sb = b % 1024, swz = sb ^ (((sb >> 9) & 1) << 5); R = (st >> 1) * 16 + swz / 64; C = (st & 1) * 32 + (swz % 64) / 2; }
__host__ __device__ __forceinline__ int perm32(int rho) { const int n = rho >> 4, i = rho & 15; return 8 * (i >> 2) + 4 * n + (i & 3); }

struct Unit { int pm, pn; };
struct Gemm { const bf16_t* A; const bf16_t* Bt; int M, N, K; };

struct StaticOrder {
    int nM, nN, nwg, G, c, reps;
    __host__ __device__ void init(int M, int N, int G_, int c_) { nM = M / BM; nN = N / BM; nwg = nM * nN; G = G_; c = c_; reps = 1; }
    __host__ __device__ bool next(int i, Unit& u) const {
        if (reps > 1) { const int nmine = (c < nwg) ? (nwg - c + G - 1) / G : 0; if (i >= reps * nmine) return false; i = i % nmine; }
        const long L = (long)i * G + c; if (L >= nwg) return false;
        int wgid = (int)L; { const int q = nwg / NXCD, r = nwg % NXCD, xcd = wgid % NXCD, off = wgid / NXCD; wgid = (xcd < r ? xcd * (q + 1) : r * (q + 1) + (xcd - r) * q) + off; }
        const int nig = WGM * nN, gid = wgid / nig, fm = gid * WGM, gsz = (nM - fm) < WGM ? (nM - fm) : WGM;
        u.pm = fm + ((wgid % nig) % gsz); u.pn = (wgid % nig) / gsz; return true;
    }
    __device__ __forceinline__ void a_ready(const Unit&) const {}
    __device__ __forceinline__ void done(const Unit&) const {}
};

__device__ __forceinline__ unsigned cvt_pk_bf16(float lo, float hi) { unsigned r; asm volatile("v_cvt_pk_bf16_f32 %0, %1, %2" : "=v"(r) : "v"(lo), "v"(hi)); return r; }
typedef float f32x2 __attribute__((ext_vector_type(2)));
__device__ __forceinline__ f32x2 gelu_pk(f32x2 v) {
    const f32x2 av = __builtin_elementwise_abs(v), d = av * 0.2316418882f + 1.0f;
    f32x2 t; t.x = __builtin_amdgcn_rcpf(d.x); t.y = __builtin_amdgcn_rcpf(d.y);
    f32x2 q = t * 0.5307027145f + (-0.7265760135f); q = q * t + 0.7107068705f; q = q * t + (-0.142248368f); q = q * t + 0.127414796f; q = q * t;
    const f32x2 s = (v * v) * (-0.72134752044f);
    f32x2 e; e.x = __builtin_amdgcn_exp2f(s.x); e.y = __builtin_amdgcn_exp2f(s.y);
    const f32x2 m = v * (q * e), r = v - m;
    f32x2 o; o.x = v.x < 0.f ? m.x : r.x; o.y = v.y < 0.f ? m.y : r.y; return o;
}

template <int ACT  > struct EpiBf16 {
    static constexpr bool PERM = true, AFTER_DRAIN = false; static_assert(ACT == 0 || ACT == 1, "EpiBf16: ACT is 0 (none) or 1 (gelu_pk)");
    bf16_t* O; int ldc; const float* bias; int split_cols; size_t split_stride; float scale0;
    __device__ __forceinline__ void operator()(const f32x4 (&acc)[2][2][4][2], const Unit& u, int wr, int wc, int fr, int fq) const {
        const int row0 = u.pm * BM + wr * 64 + fr; int colt = u.pn * BM; bf16_t* base = O;
        float sc = 1.f; if (split_cols) { const int t = colt / split_cols; base += (size_t)t * split_stride; colt -= t * split_cols; if (t == 0) sc = scale0; }
        const int col0 = colt + wc * 32 + 8 * fq, bcol0 = u.pn * BM + wc * 32 + 8 * fq;
        f32x4 bv[2][2];
#pragma unroll
        for (int bj = 0; bj < 2; ++bj)
#pragma unroll
            for (int n = 0; n < 2; ++n) bv[bj][n] = bias ? *(const f32x4*)(bias + bcol0 + bj * HALF + 4 * n) : (f32x4){0.f, 0.f, 0.f, 0.f};
#pragma unroll
        for (int ai = 0; ai < 2; ++ai)
#pragma unroll
            for (int m = 0; m < 4; ++m) { bf16_t* rowp = base + (size_t)(row0 + ai * HALF + m * 16) * ldc + col0;
#pragma unroll
                for (int bj = 0; bj < 2; ++bj) { f32x4 v0 = acc[ai][bj][m][0] + bv[bj][0], v1 = acc[ai][bj][m][1] + bv[bj][1];
                    if (ACT == 1) { f32x2 a = gelu_pk((f32x2){v0[0], v0[1]}), b = gelu_pk((f32x2){v0[2], v0[3]}), c = gelu_pk((f32x2){v1[0], v1[1]}), d = gelu_pk((f32x2){v1[2], v1[3]});
                        v0 = (f32x4){a.x, a.y, b.x, b.y}; v1 = (f32x4){c.x, c.y, d.x, d.y}; }
                    v0 = v0 * sc; v1 = v1 * sc; u32x4 w; w.x = cvt_pk_bf16(v0[0], v0[1]); w.y = cvt_pk_bf16(v0[2], v0[3]); w.z = cvt_pk_bf16(v1[0], v1[1]); w.w = cvt_pk_bf16(v1[2], v1[3]);
                    *(u32x4*)(rowp + bj * HALF) = w; } }
    }
};
template <class Epi, class Sched, bool ALIGN_EPI = false, bool SP2 = false>
__device__ __forceinline__ void gemm_phase(PG8_LAS unsigned char* lds, const Gemm g, const Sched& S, const Epi& E) {
    const int tid = threadIdx.x, wid = __builtin_amdgcn_readfirstlane(tid >> 6), lane = tid & 63, wr = wid >> 2, wc = wid & 3, fr = lane & 15, fq = lane >> 4;
    const int K = g.K, nt = K / BK;
    unsigned voffA[2], voffB[2];
#pragma unroll
    for (int i = 0; i < 2; ++i) { int R, C; stage_rc(tid * 16 + i * 8192, R, C); const int Rb = Epi::PERM ? ((R & ~31) + perm32(R & 31)) : R;
        voffA[i] = (unsigned)(R * K + C) * 2u; voffB[i] = (unsigned)(Rb * K + C) * 2u; }
    const size_t kstep = (size_t)(BK * 2);
    const size_t hstep = (size_t)HALF * K * 2;
    const size_t tstep = 2 * hstep;
    const unsigned ldsw = (unsigned)wid * 1024u;
    const int aoff = lds_byte(wr * 64 + fr, fq * 8), boff = lds_byte(wc * 32 + fr, fq * 8);
#define PG8_SA(b, h) (((b) * 2 + (h)) * HTB)
#define PG8_SB(b, h) ((4 + (b) * 2 + (h)) * HTB)
#define PG8_STAGE(bufoff, gbase, voff) do { _Pragma("unroll") for (int _i = 0; _i < 2; ++_i) \
        __builtin_amdgcn_global_load_lds((const unsigned*)((const char*)(gbase) + (voff)[_i]), (PG8_LAS unsigned*)(lds + (bufoff) + ldsw + _i * 8192), 16, 0, 0); } while (0)
#define PG8_LDA(dst, b, h) do { _Pragma("unroll") for (int m = 0; m < 4; ++m) _Pragma("unroll") for (int k = 0; k < 2; ++k) dst[m][k] = *(const PG8_LAS bf16x8*)(lds + PG8_SA(b, h) + aoff + m * 2048 + k * 1024); } while (0)
#define PG8_LDB(dst, b, h) do { _Pragma("unroll") for (int n = 0; n < 2; ++n) _Pragma("unroll") for (int k = 0; k < 2; ++k) dst[n][k] = *(const PG8_LAS bf16x8*)(lds + PG8_SB(b, h) + boff + n * 2048 + k * 1024); } while (0)
#define PG8_MMA(ai, bj, At, Bt) do { __builtin_amdgcn_s_setprio(1); _Pragma("unroll") for (int m = 0; m < 4; ++m) _Pragma("unroll") for (int n = 0; n < 2; ++n) _Pragma("unroll") for (int k = 0; k < 2; ++k) \
        acc[ai][bj][m][n] = __builtin_amdgcn_mfma_f32_16x16x32_bf16(Bt[n][k], At[m][k], acc[ai][bj][m][n], 0, 0, 0); __builtin_amdgcn_s_setprio(0); } while (0)
#define PG8_WAIT_V(n) asm volatile("s_waitcnt vmcnt(" #n ")" ::: "memory")
#define PG8_WAIT_L(n) asm volatile("s_waitcnt lgkmcnt(" #n ")" ::: "memory")
#define PG8_BAR __builtin_amdgcn_s_barrier()
#define PG8_SCHED __builtin_amdgcn_sched_barrier(0)
    Unit cur, nxt; int ui = 0;
    if (!S.next(0, cur)) return;
    f32x4 acc[2][2][4][2];
#pragma unroll
    for (int a = 0; a < 2; ++a)
#pragma unroll
        for (int b = 0; b < 2; ++b)
#pragma unroll
            for (int m = 0; m < 4; ++m)
#pragma unroll
                for (int n = 0; n < 2; ++n) acc[a][b][m][n] = (f32x4){0.f, 0.f, 0.f, 0.f};
    bf16x8 At[4][2], B0[2][2], B1[2][2];
    const char* cA = (const char*)g.A + (size_t)cur.pm * tstep; const char* cB = (const char*)g.Bt + (size_t)cur.pn * tstep;
    S.a_ready(cur);
    if constexpr (SP2) {
        PG8_STAGE(PG8_SB(0, 0), cB, voffB); PG8_STAGE(PG8_SB(0, 1), cB + hstep, voffB); PG8_STAGE(PG8_SA(0, 0), cA, voffA); PG8_STAGE(PG8_SA(0, 1), cA + hstep, voffA);
        if (wr == 1) PG8_BAR;
        PG8_WAIT_V(2); PG8_BAR;
        PG8_STAGE(PG8_SB(1, 0), cB + kstep, voffB); PG8_STAGE(PG8_SA(1, 0), cA + kstep, voffA); PG8_STAGE(PG8_SB(1, 1), cB + hstep + kstep, voffB);
        PG8_WAIT_V(6); PG8_BAR;
    } else {
        PG8_STAGE(PG8_SB(0, 0), cB, voffB); PG8_STAGE(PG8_SA(0, 0), cA, voffA); PG8_STAGE(PG8_SB(0, 1), cB + hstep, voffB); PG8_STAGE(PG8_SA(0, 1), cA + hstep, voffA);
        if (wr == 1) PG8_BAR;
        PG8_WAIT_V(4); PG8_BAR;
        PG8_STAGE(PG8_SB(1, 0), cB + kstep, voffB); PG8_STAGE(PG8_SA(1, 0), cA + kstep, voffA); PG8_STAGE(PG8_SB(1, 1), cB + hstep + kstep, voffB);
        PG8_WAIT_V(6); PG8_BAR;
    }
    for (;;) {
        const bool has_next = S.next(ui + 1, nxt);
        const char* nA = has_next ? (const char*)g.A + (size_t)nxt.pm * tstep : cA; const char* nB = has_next ? (const char*)g.Bt + (size_t)nxt.pn * tstep : cB;
        for (int t = 0; t < nt; t += 2) {
            const bool last = (t == nt - 2);
            const char* a1 = cA + (size_t)(t + 1) * kstep;
            const char* a2 = last ? nA : cA + (size_t)(t + 2) * kstep; const char* b2 = last ? nB : cB + (size_t)(t + 2) * kstep;
            const char* a3 = a2 + kstep; const char* b3 = b2 + kstep;
            if (last && has_next) S.a_ready(nxt);
            if constexpr (SP2) {
            PG8_LDB(B0, 0, 0); PG8_LDB(B1, 0, 1); PG8_SCHED; PG8_LDA(At, 0, 0); PG8_STAGE(PG8_SA(1, 1), a1 + hstep, voffA);
            PG8_WAIT_V(8); PG8_WAIT_L(0); PG8_BAR; PG8_MMA(0, 0, At, B0); PG8_MMA(0, 1, At, B1); PG8_BAR; PG8_SCHED;
            PG8_LDA(At, 0, 1); PG8_STAGE(PG8_SB(0, 0), b2, voffB); PG8_STAGE(PG8_SB(0, 1), b2 + hstep, voffB); PG8_STAGE(PG8_SA(0, 0), a2, voffA);
            PG8_WAIT_V(8); PG8_WAIT_L(0); PG8_BAR; PG8_MMA(1, 0, At, B0); PG8_MMA(1, 1, At, B1); PG8_BAR; PG8_SCHED;
            PG8_LDB(B0, 1, 0); PG8_LDB(B1, 1, 1); PG8_SCHED; PG8_LDA(At, 1, 0); PG8_STAGE(PG8_SA(0, 1), a2 + hstep, voffA);
            PG8_WAIT_V(8); PG8_WAIT_L(0); PG8_BAR; PG8_MMA(0, 0, At, B0); PG8_MMA(0, 1, At, B1); PG8_BAR; PG8_SCHED;
            PG8_LDA(At, 1, 1); PG8_STAGE(PG8_SB(1, 0), b3, voffB); PG8_STAGE(PG8_SB(1, 1), b3 + hstep, voffB); PG8_STAGE(PG8_SA(1, 0), a3, voffA);
            PG8_WAIT_V(8); PG8_WAIT_L(0); PG8_BAR; PG8_MMA(1, 0, At, B0); PG8_MMA(1, 1, At, B1); PG8_BAR; PG8_SCHED;
            } else {
            PG8_LDB(B0, 0, 0); PG8_SCHED; PG8_LDA(At, 0, 0); PG8_STAGE(PG8_SA(1, 1), a1 + hstep, voffA);
            PG8_WAIT_L(8); PG8_BAR; PG8_WAIT_L(0); PG8_MMA(0, 0, At, B0); PG8_BAR; PG8_SCHED;
            PG8_LDB(B1, 0, 1); PG8_STAGE(PG8_SB(0, 0), b2, voffB);
            PG8_BAR; PG8_WAIT_L(0); PG8_MMA(0, 1, At, B1); PG8_BAR;
            PG8_LDA(At, 0, 1); PG8_STAGE(PG8_SA(0, 0), a2, voffA);
            PG8_BAR; PG8_WAIT_L(0); PG8_MMA(1, 0, At, B0); PG8_BAR; PG8_SCHED;
            PG8_STAGE(PG8_SB(0, 1), b2 + hstep, voffB);
            PG8_WAIT_V(6); PG8_BAR; PG8_MMA(1, 1, At, B1); PG8_BAR;
            PG8_LDB(B0, 1, 0); PG8_SCHED; PG8_LDA(At, 1, 0); PG8_STAGE(PG8_SA(0, 1), a2 + hstep, voffA);
            PG8_WAIT_L(8); PG8_BAR; PG8_WAIT_L(0); PG8_MMA(0, 0, At, B0); PG8_BAR; PG8_SCHED;
            PG8_LDB(B1, 1, 1); PG8_STAGE(PG8_SB(1, 0), b3, voffB);
            PG8_BAR; PG8_WAIT_L(0); PG8_MMA(0, 1, At, B1); PG8_BAR;
            PG8_LDA(At, 1, 1); PG8_STAGE(PG8_SA(1, 0), a3, voffA);
            PG8_BAR; PG8_WAIT_L(0); PG8_MMA(1, 0, At, B0); PG8_BAR; PG8_SCHED;
            PG8_STAGE(PG8_SB(1, 1), b3 + hstep, voffB);
            PG8_WAIT_V(6); PG8_BAR; PG8_MMA(1, 1, At, B1); PG8_BAR;
            }
        }
        if constexpr (ALIGN_EPI) { if (wr == 0) PG8_BAR; }
        if constexpr (!Epi::AFTER_DRAIN) { E(acc, cur, wr, wc, fr, fq); S.done(cur); }
        if (!has_next) break;
#pragma unroll
        for (int a = 0; a < 2; ++a)
#pragma unroll
            for (int b = 0; b < 2; ++b)
#pragma unroll
                for (int m = 0; m < 4; ++m)
#pragma unroll
                    for (int n = 0; n < 2; ++n) acc[a][b][m][n] = (f32x4){0.f, 0.f, 0.f, 0.f};
        cur = nxt; cA = nA; cB = nB; ++ui;
        if constexpr (ALIGN_EPI) { if (wr == 1) PG8_BAR; }
    }
    PG8_WAIT_V(0);
    if constexpr (!ALIGN_EPI) { if (wr == 0) PG8_BAR; }
    PG8_BAR;
    if constexpr (Epi::AFTER_DRAIN) { E.fused(acc, cur, wr, wc, fr, fq, lds, wid, lane); S.done(cur); }
#undef PG8_SA
#undef PG8_SB
#undef PG8_STAGE
#undef PG8_LDA
#undef PG8_LDB
#undef PG8_MMA
#undef PG8_WAIT_V
#undef PG8_WAIT_L
#undef PG8_BAR
#undef PG8_SCHED
}
}

#define LAS __attribute__((address_space(3)))
typedef unsigned short bf16;
typedef short bf16x8 __attribute__((ext_vector_type(8)));
typedef short s16x4 __attribute__((ext_vector_type(4)));
typedef float f32x4 __attribute__((ext_vector_type(4)));
typedef float f32x16 __attribute__((ext_vector_type(16)));
typedef unsigned u32x4 __attribute__((ext_vector_type(4)));
typedef unsigned u32x2 __attribute__((ext_vector_type(2)));

constexpr int BATCH = 8, SEQ = 2048, DM = 1024, MROWS = BATCH * SEQ;
constexpr int AW = 768, DFF = 2816, NUP = 2 * DFF, NLAYER = 4;
constexpr float RMS_EPS = 1e-6f;
constexpr float LOG2E = 1.4426950408889634f;
constexpr float QSCALE = 0.125f * 1.4426950408889634f;
constexpr size_t MiB = 1u << 20;
constexpr size_t WS_ROPE = 64 * 1024;
constexpr size_t WS_WFT = 256 * 1024;
constexpr size_t WS_W = 1 * MiB;
constexpr size_t W_QK_A = WS_W, W_V_A = WS_W + 6 * MiB, W_O_A = WS_W + 9 * MiB, W_QK_B = WS_W + 12 * MiB, W_V_B = WS_W + 16 * MiB,
                 W_Q_B1 = WS_W + 18 * MiB, W_O_B = WS_W + 20 * MiB, W_UP = WS_W + 24 * MiB, W_DN = WS_W + 68 * MiB;
constexpr size_t WS_C2 = 91 * MiB, WS_FLOG = 92 * MiB, WS_LSE = 93 * MiB;
constexpr size_t WS_XN = 94 * MiB;
constexpr size_t WS_F = 126 * MiB;
constexpr size_t WS_G = 190 * MiB;
constexpr size_t G_QK_A = WS_G, G_VT_A = WS_G + 48 * MiB, G_O_A = WS_G + 72 * MiB, G_XP1 = WS_G + 96 * MiB, G_XP2 = WS_G + 128 * MiB;
constexpr size_t G_Q_B = WS_G, G_O_B = WS_G + 32 * MiB, G_K_B = WS_G + 96 * MiB, G_VT_B = WS_G + 128 * MiB;
constexpr size_t G_U = WS_G;
constexpr size_t WS_END = 352 * MiB;
constexpr int LDS_BYTES = 147456;
constexpr int LDS_MISC = 131072 + 320;
constexpr size_t WS_BAR = 16384;
constexpr int NPHASE = 1 + 9 * NLAYER;

__device__ __forceinline__ unsigned pk2(float lo, float hi) {
    typedef float f2 __attribute__((ext_vector_type(2))); typedef __bf16 b2 __attribute__((ext_vector_type(2)));
    f2 v = {lo, hi}; b2 b = __builtin_convertvector(v, b2); return __builtin_bit_cast(unsigned, b);
}
__device__ __forceinline__ float bf_lo(unsigned w) { return __uint_as_float(w << 16); }
__device__ __forceinline__ float bf_hi(unsigned w) { return __uint_as_float(w & 0xffff0000u); }
__device__ __forceinline__ float wave_sum(float v) {
#pragma unroll
    for (int o = 1; o < 64; o <<= 1) v += __shfl_xor(v, o);
    return v;
}
#define LDS_WAIT() asm volatile("s_waitcnt lgkmcnt(0)" ::: "memory")

namespace pg8 {
struct EpiF32 {
    static constexpr bool PERM = false, AFTER_DRAIN = false;
    float* O; int ldc;
    __device__ __forceinline__ void operator()(const f32x4 (&acc)[2][2][4][2], const Unit& u, int wr, int wc, int fr, int fq) const {
        const int row0 = u.pm * BM + wr * 64 + fr, col0 = u.pn * BM + wc * 32 + 4 * fq;
#pragma unroll
        for (int ai = 0; ai < 2; ++ai)
#pragma unroll
            for (int m = 0; m < 4; ++m) { float* rowp = O + (size_t)(row0 + ai * HALF + m * 16) * ldc + col0;
#pragma unroll
                for (int bj = 0; bj < 2; ++bj)
#pragma unroll
                    for (int n = 0; n < 2; ++n) *(f32x4*)(rowp + bj * HALF + n * 16) = acc[ai][bj][m][n]; }
    }
};
template <int CTRL> __device__ __forceinline__ float dppf(float old, float src) {
    return __int_as_float(__builtin_amdgcn_update_dpp(__float_as_int(old), __float_as_int(src), CTRL, 0xf, 0xf, false));
}
__device__ __forceinline__ float gelu_tanh(float x) {
    const float z = 0.7978845608028654f * (x + 0.044715f * x * x * x);
    const float e = __builtin_amdgcn_exp2f(-2.0f * 1.4426950408889634f * z);
    return x * __builtin_amdgcn_rcpf(1.0f + e);
}
struct EpiConvGlu {
    static constexpr bool PERM = true, AFTER_DRAIN = false;
    bf16_t* U; float* side; const float* cw; const float* cb;
    __device__ __forceinline__ void operator()(const f32x4 (&acc)[2][2][4][2], const Unit& u, int wr, int wc, int fr, int fq) const {
        const int chb = u.pn * HALF + wc * 32 + 8 * fq;
#pragma unroll
        for (int n = 0; n < 2; ++n) {
            const int ch = chb + 4 * n;
            const f32x4 wg0 = *(const f32x4*)(cw + ch), wg1 = *(const f32x4*)(cw + NUP + ch), wg2 = *(const f32x4*)(cw + 2 * NUP + ch), bg = *(const f32x4*)(cb + ch);
            const f32x4 wv0 = *(const f32x4*)(cw + DFF + ch), wv1 = *(const f32x4*)(cw + NUP + DFF + ch), wv2 = *(const f32x4*)(cw + 2 * NUP + DFF + ch), bv = *(const f32x4*)(cb + DFF + ch);
#pragma unroll
            for (int ai = 0; ai < 2; ++ai) {
                const int chunk = u.pm * 4 + ai * 2 + wr, rowbase = u.pm * BM + ai * HALF + wr * 64;
#pragma unroll
                for (int m = 0; m < 4; ++m) {
                    const f32x4 xg = acc[ai][0][m][n], xv = acc[ai][1][m][n];
                    if (m == 0 && fr < 2) { float* sp = side + (size_t)(chunk * 4 + fr) * NUP + ch; *(f32x4*)sp = xg; *(f32x4*)(sp + DFF) = xv; }
                    if (m == 3 && fr >= 14) { float* sp = side + (size_t)(chunk * 4 + fr - 12) * NUP + ch; *(f32x4*)sp = xg; *(f32x4*)(sp + DFF) = xv; }
                    f32x4 pg = (f32x4){0.f, 0.f, 0.f, 0.f}, pv = pg;
                    if (m > 0) { pg = acc[ai][0][m - 1][n]; pv = acc[ai][1][m - 1][n]; }
                    f32x4 g1, g2, v1, v2;
#pragma unroll
                    for (int e = 0; e < 4; ++e) {
                        g1[e] = dppf<0x111>(dppf<0x121>(0.f, pg[e]), xg[e]); g2[e] = dppf<0x112>(dppf<0x122>(0.f, pg[e]), xg[e]);
                        v1[e] = dppf<0x111>(dppf<0x121>(0.f, pv[e]), xv[e]); v2[e] = dppf<0x112>(dppf<0x122>(0.f, pv[e]), xv[e]);
                    }
                    const f32x4 cg = wg0 * g2 + wg1 * g1 + wg2 * xg + bg, cv = wv0 * v2 + wv1 * v1 + wv2 * xv + bv;
                    f32x4 o;
#pragma unroll
                    for (int e = 0; e < 4; ++e) o[e] = gelu_tanh(cg[e]) * cv[e];
                    if (!(m == 0 && fr < 2)) { u32x2 w; w.x = pk2(o[0], o[1]); w.y = pk2(o[2], o[3]); *(u32x2*)(U + (size_t)(rowbase + m * 16 + fr) * DFF + ch) = w; }
                }
            }
        }
    }
};
}

__device__ __forceinline__ void wt_item(const float* W, int ldw, int K, int k0, int ncol0, bf16* WT, int out_row0, const float* gain, float scale, LAS float* scr, int lane) {
#pragma unroll 8
    for (int i = 0; i < 32; ++i) { const int kk = 2 * i + (lane >> 5); const float g = gain ? gain[k0 + kk] * scale : scale;
        scr[kk * 33 + (lane & 31)] = W[(size_t)(k0 + kk) * ldw + ncol0 + (lane & 31)] * g; }
    LDS_WAIT();
    const int c = lane & 7;
#pragma unroll
    for (int j = 0; j < 4; ++j) { const int n = (lane >> 3) + 8 * j; const LAS float* s = scr + (8 * c) * 33 + n;
        u32x4 o; o.x = pk2(s[0 * 33], s[1 * 33]); o.y = pk2(s[2 * 33], s[3 * 33]); o.z = pk2(s[4 * 33], s[5 * 33]); o.w = pk2(s[6 * 33], s[7 * 33]);
        *(u32x4*)(WT + (size_t)(out_row0 + n) * K + k0 + 8 * c) = o; }
    LDS_WAIT();
}
__device__ __forceinline__ void conv_mat(const float* W, int ldw, int K, int col0, int ncols, bf16* WT, int mode, const float* gain, float scale,
                                         LAS float* scr, int gw, int NGW, int lane, int& off) {
    const int nnb = ncols / 32, nitems = (K / 64) * nnb;
    for (int it = (gw + NGW - off) % NGW; it < nitems; it += NGW) {
        const int kb = it / nnb, nb = it % nnb, n0 = 32 * nb;
        int out_row0 = n0;
        if (mode == 1) { const int bj = n0 / DFF, ch0 = n0 % DFF; out_row0 = 256 * (ch0 / 128) + 128 * bj + (ch0 % 128); }
        wt_item(W, ldw, K, 64 * kb, col0 + n0, WT, out_row0, gain, scale, scr, lane);
    }
    off = (off + nitems) % NGW;
}

__device__ __forceinline__ void sincos_f64(float ang, float& sn, float& cs) {
    const double x = (double)ang; const double k = __builtin_rint(x * 0.63661977236758134308);
    double r = __builtin_fma(-k, 1.57079632679489655800, x); r = __builtin_fma(-k, 6.12323399573676603587e-17, r);
    const double r2 = r * r;
    double s = 1.6059043836821613e-10; s = s * r2 - 2.5052108385441720e-08; s = s * r2 + 2.7557319223985893e-06; s = s * r2 - 1.9841269841269841e-04;
    s = s * r2 + 8.3333333333333332e-03; s = s * r2 - 1.6666666666666666e-01; s = s * r2 * r + r;
    double c = -1.1470745597729725e-11; c = c * r2 + 2.0876756987868100e-09; c = c * r2 - 2.7557319223985888e-07; c = c * r2 + 2.4801587301587302e-05;
    c = c * r2 - 1.3888888888888889e-03; c = c * r2 + 4.1666666666666664e-02; c = c * r2 - 0.5; c = c * r2 + 1.0;
    const int q = ((int)k) & 3;
    const double ss = (q == 0) ? s : (q == 1) ? c : (q == 2) ? -s : -c;
    const double cc = (q == 0) ? c : (q == 1) ? -s : (q == 2) ? -c : s;
    sn = (float)ss; cs = (float)cc;
}

template <int MODE>
__device__ __forceinline__ void row_phase(const float* src, const float* gain, float* h, bf16* xn, bf16* xp1, bf16* xp2, bool want_xn, bool want_perm,
                                          bool want_forget, const LAS float* wft, const float* bfg, float* flog, int gw, int NGW, int lane) {
    for (int m = gw; m < MROWS; m += NGW) {
        f32x4 v[4]; float ss = 0.f;
#pragma unroll
        for (int j = 0; j < 4; ++j) { v[j] = *(const f32x4*)(src + (size_t)m * DM + 4 * lane + 256 * j); ss += (v[j].x * v[j].x + v[j].y * v[j].y) + (v[j].z * v[j].z + v[j].w * v[j].w); }
        if (MODE == 1) {
            const float rs = 1.0f / sqrtf(wave_sum(ss) * (1.0f / DM) + RMS_EPS); ss = 0.f;
#pragma unroll
            for (int j = 0; j < 4; ++j) { const f32x4 g = *(const f32x4*)(gain + 4 * lane + 256 * j); const f32x4 ho = *(const f32x4*)(h + (size_t)m * DM + 4 * lane + 256 * j);
                v[j] = ho + v[j] * rs * g; ss += (v[j].x * v[j].x + v[j].y * v[j].y) + (v[j].z * v[j].z + v[j].w * v[j].w); }
        }
#pragma unroll
        for (int j = 0; j < 4; ++j) *(f32x4*)(h + (size_t)m * DM + 4 * lane + 256 * j) = v[j];
        if (want_xn) {
            const float rs2 = 1.0f / sqrtf(wave_sum(ss) * (1.0f / DM) + RMS_EPS);
#pragma unroll
            for (int j = 0; j < 4; ++j) v[j] = v[j] * rs2;
            u32x2 w[4];
#pragma unroll
            for (int j = 0; j < 4; ++j) { w[j].x = pk2(v[j].x, v[j].y); w[j].y = pk2(v[j].z, v[j].w); *(u32x2*)(xn + (size_t)m * DM + 4 * lane + 256 * j) = w[j]; }
            if (want_perm) {
                const int b = m / SEQ, t = m % SEQ;
                const size_t m1 = (size_t)b * SEQ + (t & 3) * 512 + (t >> 2), m2 = (size_t)b * SEQ + (t & 15) * 128 + (t >> 4);
#pragma unroll
                for (int j = 0; j < 4; ++j) { *(u32x2*)(xp1 + m1 * DM + 4 * lane + 256 * j) = w[j]; *(u32x2*)(xp2 + m2 * DM + 4 * lane + 256 * j) = w[j]; }
            }
            if (want_forget) {
                float mine = 0.f;
#pragma unroll 4
                for (int hd = 0; hd < 16; ++hd) { float a = 0.f;
#pragma unroll
                    for (int j = 0; j < 4; ++j) { const f32x4 wv = *(const LAS f32x4*)(wft + hd * DM + 4 * lane + 256 * j); a += (v[j].x * wv.x + v[j].y * wv.y) + (v[j].z * wv.z + v[j].w * wv.w); }
                    a = wave_sum(a); if (lane == hd) mine = a; }
                if (lane < 16) flog[(size_t)m * 16 + lane] = mine + bfg[lane];
            }
        }
    }
}

__device__ __forceinline__ float log_sigmoid(float x) { return fminf(x, 0.f) - logf(1.0f + expf(-fabsf(x))); }
__device__ __forceinline__ void scan_unit(const float* flog, float* c2, int bh, int lane) {
    const int b = bh >> 4, hd = bh & 15; const float* fp = flog + ((size_t)b * SEQ + 32 * lane) * 16 + hd;
    float tot = 0.f;
    for (int i = 0; i < 32; ++i) tot += log_sigmoid(fp[i * 16]);
    float inc = tot;
#pragma unroll
    for (int o = 1; o < 64; o <<= 1) { const float t = __shfl_up(inc, o); if (lane >= o) inc += t; }
    float run = inc - tot;
    float* cp = c2 + (size_t)bh * SEQ + 32 * lane;
    for (int i = 0; i < 32; ++i) { run += log_sigmoid(fp[i * 16]); cp[i] = run * LOG2E; }
}

struct AttnHalf {
    const bf16* Q; const bf16* K; const bf16* VT; bf16* O; float* lse; const float* cq;
    int q_stride, k_stride, vt_pitch, o_stride, lse_stride;
    int q0, kv_begin, nback, pos0, pos_step;
};
constexpr int AT_PITCH = 144, AT_K = 0, AT_V = 9216, AT_CK = 18432, AT_BUF = 18688, AT_HALF = 2 * AT_BUF;
__device__ __forceinline__ int crow(int r, int hi) { return (r & 3) + 8 * (r >> 2) + 4 * hi; }
__device__ __forceinline__ void rope16(u32x4& a, u32x4& b, const float* ct, const float* st) {
    const f32x4 c0 = *(const f32x4*)ct, c1 = *(const f32x4*)(ct + 4), s0 = *(const f32x4*)st, s1 = *(const f32x4*)(st + 4);
#define RC_(k) ((k) < 4 ? c0[(k) & 3] : c1[(k) & 3])
#define RS_(k) ((k) < 4 ? s0[(k) & 3] : s1[(k) & 3])
    u32x4 oa, ob;
#pragma unroll
    for (int i = 0; i < 4; ++i) {
        const float x1l = bf_lo(a[i]), x1h = bf_hi(a[i]), x2l = bf_lo(b[i]), x2h = bf_hi(b[i]);
        oa[i] = pk2(x1l * RC_(2 * i) - x2l * RS_(2 * i), x1h * RC_(2 * i + 1) - x2h * RS_(2 * i + 1));
        ob[i] = pk2(x2l * RC_(2 * i) + x1l * RS_(2 * i), x2h * RC_(2 * i + 1) + x1h * RS_(2 * i + 1));
    }
    a = oa; b = ob;
#undef RC_
#undef RS_
}

template <int QB, bool ROPE, bool BIAS>
__device__ __forceinline__ void attn_super(const AttnHalf& U, int ntiles, LAS unsigned char* ldsbase, const float* ropetab, int tid) {
    const int lane = tid & 63, r32 = lane & 31, hi = lane >> 5, tidh = tid & 255, waveh = (tid >> 6) & 3, half = tid >> 8;
    LAS unsigned char* lds = ldsbase + half * AT_HALF;
    const int qlo = U.q0 + waveh * 32 * QB, qhi = qlo + 32 * QB - 1;
    bf16x8 qf[QB][4]; float cqv[QB];
#pragma unroll
    for (int qb = 0; qb < QB; ++qb) {
        const int qi = qlo + 32 * qb + r32; const bf16* src = U.Q + (size_t)qi * U.q_stride;
#pragma unroll
        for (int d0 = 0; d0 < 4; ++d0) qf[qb][d0] = *(const bf16x8*)(src + 16 * d0 + 8 * hi);
        if (ROPE) { u32x4 a = *(const u32x4*)src, b = *(const u32x4*)(src + 8); const int pos = U.pos0 + qi * U.pos_step;
            rope16(a, b, ropetab + pos * 8, ropetab + SEQ * 8 + pos * 8); qf[qb][0] = __builtin_bit_cast(bf16x8, hi ? b : a); }
        cqv[qb] = BIAS ? U.cq[qi] : 0.f;
    }
    f32x16 OT[QB][2]; float mrun[QB], lrun[QB];
#pragma unroll
    for (int qb = 0; qb < QB; ++qb) { mrun[qb] = -1e30f; lrun[qb] = 0.f;
#pragma unroll
        for (int dh = 0; dh < 2; ++dh)
#pragma unroll
            for (int r = 0; r < 16; ++r) OT[qb][dh][r] = 0.f; }
    u32x4 kr0, kr1, vr0, vr1; f32x4 ckr = (f32x4){0.f, 0.f, 0.f, 0.f};
    const int trow = tidh >> 2, tseg = tidh & 3;
#define AT_LOAD(t) do { const int kv0_ = U.kv_begin + 64 * (t); const int kvc_ = kv0_ < 0 ? 0 : kv0_; \
        const bf16* ks_ = U.K + (size_t)(kvc_ + trow) * U.k_stride + 16 * tseg; kr0 = *(const u32x4*)ks_; kr1 = *(const u32x4*)(ks_ + 8); \
        const bf16* vs_ = U.VT + (size_t)trow * U.vt_pitch + kvc_ + 16 * tseg; vr0 = *(const u32x4*)vs_; vr1 = *(const u32x4*)(vs_ + 8); \
        if (BIAS) { if (tidh < 16) ckr = *(const f32x4*)(U.cq + kvc_ + 4 * tidh); } \
        if (ROPE) { if (tseg == 0) { const int pos_ = U.pos0 + (kvc_ + trow) * U.pos_step; rope16(kr0, kr1, ropetab + pos_ * 8, ropetab + SEQ * 8 + pos_ * 8); } } } while (0)
#define AT_STORE(buf) do { LAS unsigned char* b_ = lds + (buf) * AT_BUF; \
        *(LAS u32x4*)(b_ + AT_K + trow * AT_PITCH + tseg * 32) = kr0; *(LAS u32x4*)(b_ + AT_K + trow * AT_PITCH + tseg * 32 + 16) = kr1; \
        *(LAS u32x4*)(b_ + AT_V + trow * AT_PITCH + tseg * 32) = vr0; *(LAS u32x4*)(b_ + AT_V + trow * AT_PITCH + tseg * 32 + 16) = vr1; \
        if (BIAS) { if (tidh < 16) *(LAS f32x4*)(b_ + AT_CK + 16 * tidh) = ckr; } } while (0)
    AT_LOAD(0); AT_STORE(0);
    __syncthreads();
    for (int t = 0; t < ntiles; ++t) {
        if (t + 1 < ntiles) AT_LOAD(t + 1);
        const LAS unsigned char* bb = lds + (t & 1) * AT_BUF;
        const int kv0 = U.kv_begin + 64 * t;
#pragma unroll
        for (int kb = 0; kb < 2; ++kb) {
            const int kvb = kv0 + 32 * kb;
            if (kvb < 0 || kvb > qhi || qlo - (kvb + 31) > U.nback) continue;
            bf16x8 kf[4];
#pragma unroll
            for (int d0 = 0; d0 < 4; ++d0) kf[d0] = *(const LAS bf16x8*)(bb + AT_K + (32 * kb + r32) * AT_PITCH + (16 * d0 + 8 * hi) * 2);
            f32x4 ck4[4];
            if (BIAS) {
#pragma unroll
                for (int jj = 0; jj < 4; ++jj) ck4[jj] = *(const LAS f32x4*)(bb + AT_CK + (32 * kb + 8 * jj + 4 * hi) * 4);
            }
            bf16x8 pa[QB][2];
#pragma unroll
            for (int qb = 0; qb < QB; ++qb) {
                f32x16 S;
#pragma unroll
                for (int r = 0; r < 16; ++r) S[r] = 0.f;
#pragma unroll
                for (int d0 = 0; d0 < 4; ++d0) S = __builtin_amdgcn_mfma_f32_32x32x16_bf16(kf[d0], qf[qb][d0], S, 0, 0, 0);
                const int qb0 = qlo + 32 * qb, qi = qb0 + r32;
                if (BIAS) {
#pragma unroll
                    for (int r = 0; r < 16; ++r) S[r] += cqv[qb] - ck4[r >> 2][r & 3];
                }
                if (kvb + 31 > qb0 || qb0 + 31 - kvb > U.nback) {
#pragma unroll
                    for (int r = 0; r < 16; ++r) { const int kvj = kvb + crow(r, hi); const bool ok = (kvj <= qi) && (qi - kvj <= U.nback); S[r] = ok ? S[r] : -INFINITY; }
                }
                float mx = S[0];
#pragma unroll
                for (int r = 1; r < 16; ++r) mx = fmaxf(mx, S[r]);
                mx = fmaxf(mx, __shfl_xor(mx, 32));
                const float mnew = fmaxf(mrun[qb], mx);
                const float alpha = __builtin_amdgcn_exp2f(mrun[qb] - mnew);
                if (__any(mnew > mrun[qb])) {
#pragma unroll
                    for (int dh = 0; dh < 2; ++dh)
#pragma unroll
                        for (int r = 0; r < 16; ++r) OT[qb][dh][r] *= alpha;
                }
                mrun[qb] = mnew;
                float ps = 0.f;
#pragma unroll
                for (int r = 0; r < 16; ++r) { S[r] = __builtin_amdgcn_exp2f(S[r] - mnew); ps += S[r]; }
                lrun[qb] = lrun[qb] * alpha + ps;
#pragma unroll
                for (int ks = 0; ks < 2; ++ks) { u32x4 w; w.x = pk2(S[8 * ks], S[8 * ks + 1]); w.y = pk2(S[8 * ks + 2], S[8 * ks + 3]); w.z = pk2(S[8 * ks + 4], S[8 * ks + 5]); w.w = pk2(S[8 * ks + 6], S[8 * ks + 7]);
                    pa[qb][ks] = __builtin_bit_cast(bf16x8, w); }
            }
#pragma unroll
            for (int ks = 0; ks < 2; ++ks)
#pragma unroll
                for (int dh = 0; dh < 2; ++dh) {
                    const LAS unsigned char* vp = bb + AT_V + (32 * dh + r32) * AT_PITCH + (32 * kb + 16 * ks + 4 * hi) * 2;
                    const s16x4 lo = *(const LAS s16x4*)vp, hi4 = *(const LAS s16x4*)(vp + 16);
                    const bf16x8 vf = (bf16x8){lo[0], lo[1], lo[2], lo[3], hi4[0], hi4[1], hi4[2], hi4[3]};
#pragma unroll
                    for (int qb = 0; qb < QB; ++qb) OT[qb][dh] = __builtin_amdgcn_mfma_f32_32x32x16_bf16(vf, pa[qb][ks], OT[qb][dh], 0, 0, 0);
                }
        }
        if (t + 1 < ntiles) AT_STORE((t + 1) & 1);
        __syncthreads();
    }
#undef AT_LOAD
#undef AT_STORE
#pragma unroll
    for (int qb = 0; qb < QB; ++qb) {
        const float l = lrun[qb] + __shfl_xor(lrun[qb], 32); const float inv = 1.0f / l;
        const int qi = qlo + 32 * qb + r32; bf16* op = U.O + (size_t)qi * U.o_stride;
#pragma unroll
        for (int dh = 0; dh < 2; ++dh)
#pragma unroll
            for (int r4 = 0; r4 < 4; ++r4) { u32x2 w; w.x = pk2(OT[qb][dh][4 * r4] * inv, OT[qb][dh][4 * r4 + 1] * inv); w.y = pk2(OT[qb][dh][4 * r4 + 2] * inv, OT[qb][dh][4 * r4 + 3] * inv);
                *(u32x2*)(op + 32 * dh + 8 * r4 + 4 * hi) = w; }
        if (U.lse && hi == 0) U.lse[(size_t)qi * U.lse_stride] = mrun[qb] + __builtin_amdgcn_logf(l);
    }
}

#define XB_TMO      128
#define XB_XCNT(j)  (256  + 64 * (j))
#define XB_XSUB(j)  (1280 + 64 * (j))
#define XB_XGEN(j)  (2304 + 64 * (j))
#define XB_TOP      3328
#define XB_TOPGEN   3392
#define XCD_BAR_WORDS 3456
#define XB_SPIN_CAP (1u << 18)

__device__ __forceinline__ unsigned xb_ld(unsigned* p)              { return __hip_atomic_load(p, __ATOMIC_RELAXED, __HIP_MEMORY_SCOPE_AGENT); }
__device__ __forceinline__ unsigned xb_add(unsigned* p, unsigned v) { return __hip_atomic_fetch_add(p, v, __ATOMIC_RELAXED, __HIP_MEMORY_SCOPE_AGENT); }
__device__ __forceinline__ unsigned xb_xcc_id() { return (unsigned)__builtin_amdgcn_s_getreg((3 << 11) | 20) & 0xFu; }
#define XB_SPIN(cond, bar) do { unsigned _sp = 0; while (cond) { __builtin_amdgcn_s_sleep(1); \
    if ((++_sp & 255u) == 0u) { if (xb_ld(&(bar)[XB_TMO])) break; if (_sp > XB_SPIN_CAP) { atomicAdd(&(bar)[XB_TMO], 1u); break; } } } } while (0)

struct XcdBarrier {
    unsigned* bar; unsigned x;
    volatile LAS unsigned* st;
};

__device__ __forceinline__ XcdBarrier xcd_barrier_post(unsigned* bar, volatile LAS unsigned* st) {
    XcdBarrier b; b.bar = bar; b.x = xb_xcc_id(); b.st = st;
    if (threadIdx.x == 0) (void)xb_add(&bar[XB_XCNT(b.x)], 1u);
    return b;
}
__device__ __forceinline__ void xcd_barrier_complete(unsigned* bar, unsigned x, unsigned& nloc, unsigned& nx) {
    const unsigned G = gridDim.x * gridDim.y * gridDim.z;
    unsigned sum, cnt, mine, sp = 0u;
    for (;;) {
        sum = 0u; cnt = 0u; mine = 0u;
#pragma unroll
        for (unsigned j = 0; j < 16; ++j) { const unsigned c = xb_ld(&bar[XB_XCNT(j)]); sum += c; cnt += (c > 0u) ? 1u : 0u; mine = (j == x) ? c : mine; }
        if (sum == G) break;
        __builtin_amdgcn_s_sleep(1);
        if ((++sp & 255u) == 0u) { if (xb_ld(&bar[XB_TMO])) break; if (sp > XB_SPIN_CAP) { atomicAdd(&bar[XB_TMO], 1u); break; } }
    }
    nloc = mine > 0u ? mine : 1u; nx = cnt > 0u ? cnt : 1u;
}

__device__ __forceinline__ void xcd_barrier(const XcdBarrier& b) {
    asm volatile("s_waitcnt vmcnt(0)" ::: "memory");
    __syncthreads();
    if (threadIdx.x == 0) {
        unsigned* bar = b.bar;
        __builtin_amdgcn_s_waitcnt(0);
        unsigned nloc = b.st[0], nx = b.st[1];
        if (nloc == 0u) { xcd_barrier_complete(bar, b.x, nloc, nx); b.st[0] = nloc; b.st[1] = nx; }
        const unsigned old = xb_add(&bar[XB_XSUB(b.x)], 1u);
        const unsigned gen = old / nloc;
        if (old + 1u == (gen + 1u) * nloc) {
            __builtin_amdgcn_fence(__ATOMIC_RELEASE, "agent");
            asm volatile("s_waitcnt vmcnt(0)" ::: "memory");
            const unsigned og = xb_add(&bar[XB_TOP], 1u);
            const unsigned tg = og / nx;
            if (og + 1u == (tg + 1u) * nx) xb_add(&bar[XB_TOPGEN], 1u);
            else XB_SPIN(xb_ld(&bar[XB_TOPGEN]) == tg, bar);
            __builtin_amdgcn_fence(__ATOMIC_ACQUIRE, "agent");
            xb_add(&bar[XB_XGEN(b.x)], 1u);
            asm volatile("s_waitcnt vmcnt(0)" ::: "memory");
        } else {
            XB_SPIN(xb_ld(&bar[XB_XGEN(b.x)]) == gen, bar);
            __builtin_amdgcn_fence(__ATOMIC_ACQUIRE, "agent");
            asm volatile("s_waitcnt vmcnt(0)" ::: "memory");
        }
    }
    __syncthreads();
}

struct Args { const float* in[13]; float* out; unsigned char* ws; float invf[8]; int ph_lo, ph_hi; };
enum { IN_X = 0, IN_GAINS, IN_WQKV_A, IN_WO_A, IN_WQ_B, IN_WO_B, IN_KVNORM, IN_WKVF, IN_BF, IN_WUP, IN_CONVW, IN_CONVB, IN_WDOWN };

__host__ __device__ inline bool phase_noop(int ph) { if (ph == 0) return false; const int l = (ph - 1) / 9, s = (ph - 1) % 9; return (s == 2 && l >= 2); }

#define PH_LOCALS() \
    int tid = threadIdx.x; asm volatile("" : "+v"(tid)); \
    const int lane = tid & 63, wave = __builtin_amdgcn_readfirstlane(tid >> 6); \
    const int G = gridDim.x, bx = blockIdx.x, gw = bx * 8 + wave, NGW = G * 8; \
    unsigned char* ws = a.ws; float* h = a.out; \
    bf16* xn = (bf16*)(ws + WS_XN); float* Fb = (float*)(ws + WS_F); \
    const float* gains = a.in[IN_GAINS]; const float* ropetab = (const float*)(ws + WS_ROPE); \
    (void)lane; (void)wave; (void)gw; (void)NGW; (void)h; (void)xn; (void)Fb; (void)gains; (void)ropetab; (void)G; (void)bx
#ifndef PROBE_REP
#define PROBE_REP 0
#endif
#ifndef PROBE_SYNC2
#define PROBE_SYNC2 0
#endif
__host__ __device__ constexpr int phase_reps_raw(int k) { return (k == 0) ? (((PROBE_REP >> 9) & 1) ? 2 : 1) : (((PROBE_REP >> ((k - 1) % 9)) & 1) ? 2 : 1); }
__host__ __device__ constexpr bool phase_is_gemm(int k) { return k > 0 && (((k - 1) % 9) == 0 || ((k - 1) % 9) == 3 || ((k - 1) % 9) == 5 || ((k - 1) % 9) == 7); }
__host__ __device__ constexpr int phase_reps(int k) { return phase_is_gemm(k) ? 1 : phase_reps_raw(k); }
#define PH_BEGIN(k) if (a.ph_lo <= (k) && (k) < a.ph_hi) { for (int rep_ = 0; rep_ < phase_reps(k); ++rep_) { if (rep_) grid.sync(); PH_LOCALS();
#define SEAM1(k) do { if ((k) == 0) { grid.sync(); (void)xcd_barrier_post((unsigned*)(a.ws + WS_BAR), (volatile LAS unsigned*)(lds + LDS_MISC)); } \
    else { XcdBarrier b_; b_.bar = (unsigned*)(a.ws + WS_BAR); b_.x = xb_xcc_id(); b_.st = (volatile LAS unsigned*)(lds + LDS_MISC); xcd_barrier(b_); } } while (0)
#define PH_END(k) } if ((k) + 1 < a.ph_hi) { SEAM1(k); if (PROBE_SYNC2 && (k) != 0) SEAM1(k); } }

template <int L>
__device__ __forceinline__ void run_layer(const Args& a, LAS unsigned char* lds, cg::grid_group& grid) {
    constexpr int base = 1 + 9 * L; constexpr bool isA = L < 2; constexpr int l = L;
    PH_BEGIN(base + 0)
        if (L == 2) { if (gw < BATCH * 16) scan_unit((const float*)(ws + WS_FLOG), (float*)(ws + WS_C2), gw, lane); }
        constexpr int njobs = isA ? 4 : (L == 2 ? 2 : 1);
        for (int j = 0; j < njobs; ++j) {
            pg8::Gemm g; bf16* O; int ldc, split = 0, rot = 0; size_t sstride = 0;
            if (isA) {
                if (j == 0) { g = pg8::Gemm{xn, (const bf16*)(ws + W_QK_A + l * 3 * MiB), MROWS, 1536, DM}; O = (bf16*)(ws + G_QK_A); ldc = 1536; }
                else { const bf16* Bt = (j == 1) ? xn : (j == 2) ? (const bf16*)(ws + G_XP1) : (const bf16*)(ws + G_XP2);
                    g = pg8::Gemm{(const bf16*)(ws + W_V_A + l * 3 * MiB / 2) + (size_t)(j - 1) * 256 * DM, Bt, 256, MROWS, DM};
                    O = (bf16*)(ws + G_VT_A) + (size_t)(j - 1) * 256 * MROWS; ldc = MROWS; rot = (j == 1) ? 128 : (j == 2) ? 64 : 0; }
            } else if (L == 2) {
                if (j == 0) { g = pg8::Gemm{xn, (const bf16*)(ws + W_QK_B), MROWS, 2048, DM}; O = (bf16*)(ws + G_Q_B); ldc = DM; split = DM; sstride = (G_K_B - G_Q_B) / 2; }
                else { g = pg8::Gemm{(const bf16*)(ws + W_V_B), xn, DM, MROWS, DM}; O = (bf16*)(ws + G_VT_B); ldc = MROWS; }
            } else { g = pg8::Gemm{xn, (const bf16*)(ws + W_Q_B1), MROWS, DM, DM}; O = (bf16*)(ws + G_Q_B); ldc = DM; }
            pg8::StaticOrder S; S.init(g.M, g.N, G, (bx + rot) % G); S.reps = phase_reps_raw(base + 0);
            pg8::EpiBf16<0> E{O, ldc, nullptr, split, sstride, 1.f};
            pg8::gemm_phase<pg8::EpiBf16<0>, pg8::StaticOrder, true, true>(lds, g, S, E);
            __syncthreads();
        }
    PH_END(base + 0)
    PH_BEGIN(base + 1)
        if (isA) {
            for (int su = bx; su < 768; su += G) {
                const int grp = su >> 8, hu = 2 * (su & 255) + (tid >> 8);
                const int r = (grp == 0) ? 1 : (grp == 1) ? 4 : 16, Lq = SEQ / r, nqb = Lq / 128;
                const int j = hu & 3, qb = (hu >> 2) % nqb, sq = (hu >> 2) / nqb, b = sq / r, rho = sq % r, hd12 = grp * 4 + j;
                AttnHalf U;
                const size_t row0 = (size_t)b * SEQ + rho;
                U.Q = (const bf16*)(ws + G_QK_A) + row0 * 1536 + hd12 * 64; U.K = U.Q + 768; U.q_stride = r * 1536; U.k_stride = r * 1536;
                U.VT = (const bf16*)(ws + G_VT_A) + (size_t)(grp * 256 + j * 64) * MROWS + (size_t)b * SEQ + (size_t)rho * Lq; U.vt_pitch = MROWS;
                U.O = (bf16*)(ws + G_O_A) + row0 * AW + hd12 * 64; U.o_stride = r * AW;
                U.lse = (float*)(ws + WS_LSE) + row0 * 12 + hd12; U.lse_stride = r * 12; U.cq = nullptr;
                U.q0 = qb * 128; U.kv_begin = U.q0 - 128; U.nback = 128; U.pos0 = rho; U.pos_step = r;
                attn_super<1, true, false>(U, 4, lds, ropetab, tid);
            }
        } else {
            for (int i = 0; i < 4; ++i) {
                for (int w = bx; w < 256; w += G) {
                    const int pair = w >> 2, sx = w & 3, qb = (i == 0) ? sx : (i == 1) ? 15 - sx : (i == 2) ? 4 + sx : 11 - sx;
                    const int b = pair >> 3, hd = 2 * (pair & 7) + (tid >> 8);
                    AttnHalf U;
                    U.Q = (const bf16*)(ws + G_Q_B) + (size_t)b * SEQ * DM + hd * 64; U.K = (const bf16*)(ws + G_K_B) + (size_t)b * SEQ * DM + hd * 64; U.q_stride = DM; U.k_stride = DM;
                    U.VT = (const bf16*)(ws + G_VT_B) + (size_t)(hd * 64) * MROWS + (size_t)b * SEQ; U.vt_pitch = MROWS;
                    U.O = (bf16*)(ws + G_O_B) + (size_t)b * SEQ * DM + hd * 64; U.o_stride = DM; U.lse = nullptr; U.lse_stride = 0;
                    U.cq = (const float*)(ws + WS_C2) + (size_t)(b * 16 + hd) * SEQ;
                    U.q0 = qb * 128; U.kv_begin = 0; U.nback = 1 << 30; U.pos0 = 0; U.pos_step = 0;
                    attn_super<1, false, true>(U, 2 * (qb + 1), lds, ropetab, tid);
                }
            }
        }
    PH_END(base + 1)
    if (isA) {
    PH_BEGIN(base + 2)
        const float* lse = (const float*)(ws + WS_LSE); bf16* o = (bf16*)(ws + G_O_A);
        for (int idx = bx * 512 + tid; idx < MROWS * 96; idx += G * 512) {
            const int m = idx / 96, hd12 = (idx >> 3) % 12, j = hd12 & 3, grp = hd12 >> 2;
            const float l0 = lse[(size_t)m * 12 + j], l1 = lse[(size_t)m * 12 + 4 + j], l2 = lse[(size_t)m * 12 + 8 + j];
            const float mx = fmaxf(l0, fmaxf(l1, l2));
            const float e0 = __builtin_amdgcn_exp2f(l0 - mx), e1 = __builtin_amdgcn_exp2f(l1 - mx), e2 = __builtin_amdgcn_exp2f(l2 - mx);
            const float wgt = ((grp == 0) ? e0 : (grp == 1) ? e1 : e2) / (e0 + e1 + e2);
            u32x4 v = *(const u32x4*)(o + (size_t)idx * 8);
#pragma unroll
            for (int e = 0; e < 4; ++e) v[e] = pk2(bf_lo(v[e]) * wgt, bf_hi(v[e]) * wgt);
            *(u32x4*)(o + (size_t)idx * 8) = v;
        }
    PH_END(base + 2)
    }
    PH_BEGIN(base + 3)
        pg8::Gemm g;
        if (isA) g = pg8::Gemm{(const bf16*)(ws + G_O_A), (const bf16*)(ws + W_O_A + l * 3 * MiB / 2), MROWS, DM, AW};
        else g = pg8::Gemm{(const bf16*)(ws + G_O_B), (const bf16*)(ws + W_O_B + (l - 2) * 2 * MiB), MROWS, DM, DM};
        pg8::StaticOrder S; S.init(g.M, g.N, G, bx); S.reps = phase_reps_raw(base + 3);
        pg8::EpiF32 E{Fb, DM};
        pg8::gemm_phase<pg8::EpiF32, pg8::StaticOrder, true, true>(lds, g, S, E);
    PH_END(base + 3)
    PH_BEGIN(base + 4)
        row_phase<1>(Fb, gains + (l * 4 + 1) * DM, h, xn, nullptr, nullptr, true, false, false, (const LAS float*)lds, nullptr, nullptr, gw, NGW, lane);
    PH_END(base + 4)
    PH_BEGIN(base + 5)
        pg8::Gemm g{xn, (const bf16*)(ws + W_UP + l * 11 * MiB), MROWS, NUP, DM};
        pg8::StaticOrder S; S.init(g.M, g.N, G, bx); S.reps = phase_reps_raw(base + 5);
        pg8::EpiConvGlu E{(bf16*)(ws + G_U), Fb, a.in[IN_CONVW] + (size_t)l * 3 * NUP, a.in[IN_CONVB] + (size_t)l * NUP};
        pg8::gemm_phase<pg8::EpiConvGlu, pg8::StaticOrder, true, true>(lds, g, S, E);
    PH_END(base + 5)
    PH_BEGIN(base + 6)
        const float* side = Fb; const float* cw = a.in[IN_CONVW] + (size_t)l * 3 * NUP; const float* cb = a.in[IN_CONVB] + (size_t)l * NUP; bf16* Ub = (bf16*)(ws + G_U);
        for (int idx = bx * 512 + tid; idx < 256 * 2 * 704; idx += G * 512) {
            const int cg4 = idx % 704, rr = (idx / 704) & 1, c = idx / 1408, ch = 4 * cg4; const bool first = (c % 32) == 0;
            f32x4 o;
#pragma unroll
            for (int hv = 0; hv < 2; ++hv) {
                const int col = hv * DFF + ch; const f32x4 z = (f32x4){0.f, 0.f, 0.f, 0.f};
                const f32x4 s0 = *(const f32x4*)(side + (size_t)(c * 4 + 0) * NUP + col);
                const f32x4 p3 = first ? z : *(const f32x4*)(side + (size_t)(c * 4 - 1) * NUP + col);
                f32x4 at, at1, at2;
                if (rr == 0) { at = s0; at1 = p3; at2 = first ? z : *(const f32x4*)(side + (size_t)(c * 4 - 2) * NUP + col); }
                else { at = *(const f32x4*)(side + (size_t)(c * 4 + 1) * NUP + col); at1 = s0; at2 = p3; }
                const f32x4 r = *(const f32x4*)(cw + col) * at2 + *(const f32x4*)(cw + NUP + col) * at1 + *(const f32x4*)(cw + 2 * NUP + col) * at + *(const f32x4*)(cb + col);
                if (hv == 0) { o.x = pg8::gelu_tanh(r.x); o.y = pg8::gelu_tanh(r.y); o.z = pg8::gelu_tanh(r.z); o.w = pg8::gelu_tanh(r.w); } else o = o * r;
            }
            u32x2 w; w.x = pk2(o.x, o.y); w.y = pk2(o.z, o.w);
            *(u32x2*)(Ub + (size_t)(c * 64 + rr) * DFF + ch) = w;
        }
    PH_END(base + 6)
    PH_BEGIN(base + 7)
        pg8::Gemm g{(const bf16*)(ws + G_U), (const bf16*)(ws + W_DN + l * 11 * MiB / 2), MROWS, DM, DFF};
        pg8::StaticOrder S; S.init(g.M, g.N, G, bx); S.reps = phase_reps_raw(base + 7);
        pg8::EpiF32 E{Fb, DM};
        pg8::gemm_phase<pg8::EpiF32, pg8::StaticOrder, true, true>(lds, g, S, E);
    PH_END(base + 7)
    PH_BEGIN(base + 8)
        constexpr bool last = (L == NLAYER - 1), forget = (L == 1);
        if (forget) { const float* wsrc = (const float*)(ws + WS_WFT); LAS float* wl = (LAS float*)lds;
            for (int i = tid; i < 16 * DM / 4; i += 512) *(LAS f32x4*)(wl + 4 * i) = *(const f32x4*)(wsrc + 4 * i);
            __syncthreads(); }
        row_phase<1>(Fb, gains + (l * 4 + 3) * DM, h, xn, (bf16*)(ws + G_XP1), (bf16*)(ws + G_XP2), !last, L == 0, forget, (const LAS float*)lds, a.in[IN_BF], (float*)(ws + WS_FLOG), gw, NGW, lane);
    PH_END(base + 8)
}

__global__ void __launch_bounds__(512, 2) yoco_fwd(Args a) {
    extern __shared__ __attribute__((aligned(16))) unsigned char lds_raw[];
    LAS unsigned char* lds = (LAS unsigned char*)lds_raw;
    cg::grid_group grid = cg::this_grid();
    if (threadIdx.x < 2) ((volatile LAS unsigned*)(lds + LDS_MISC))[threadIdx.x] = 0u;
    __syncthreads();
    PH_BEGIN(0)
        if (bx == 0) { unsigned* bw = (unsigned*)(ws + WS_BAR); for (int i = tid; i < XCD_BAR_WORDS; i += 512) bw[i] = 0u; }
        LAS float* scr = (LAS float*)(lds + wave * 16384);
        int off = 0;
        for (int l = 0; l < 2; ++l) {
            const float* g0 = gains + (l * 4 + 0) * DM; const float* W = a.in[IN_WQKV_A] + (size_t)l * DM * 2304;
            conv_mat(W, 2304, DM, 0, 768, (bf16*)(ws + W_QK_A + l * 3 * MiB), 0, g0, QSCALE, scr, gw, NGW, lane, off);
            conv_mat(W, 2304, DM, 768, 768, (bf16*)(ws + W_QK_A + l * 3 * MiB) + (size_t)768 * DM, 0, g0, 1.f, scr, gw, NGW, lane, off);
            conv_mat(W, 2304, DM, 1536, 768, (bf16*)(ws + W_V_A + l * 3 * MiB / 2), 0, g0, 1.f, scr, gw, NGW, lane, off);
            conv_mat(a.in[IN_WO_A] + (size_t)l * AW * DM, DM, AW, 0, DM, (bf16*)(ws + W_O_A + l * 3 * MiB / 2), 0, nullptr, 1.f, scr, gw, NGW, lane, off);
        }
        {
            const float* kvn = a.in[IN_KVNORM];
            conv_mat(a.in[IN_WQ_B], DM, DM, 0, DM, (bf16*)(ws + W_QK_B), 0, gains + (2 * 4 + 0) * DM, QSCALE, scr, gw, NGW, lane, off);
            conv_mat(a.in[IN_WKVF], 2064, DM, 0, DM, (bf16*)(ws + W_QK_B) + (size_t)DM * DM, 0, kvn, 1.f, scr, gw, NGW, lane, off);
            conv_mat(a.in[IN_WKVF], 2064, DM, DM, DM, (bf16*)(ws + W_V_B), 0, kvn, 1.f, scr, gw, NGW, lane, off);
            conv_mat(a.in[IN_WQ_B] + (size_t)DM * DM, DM, DM, 0, DM, (bf16*)(ws + W_Q_B1), 0, gains + (3 * 4 + 0) * DM, QSCALE, scr, gw, NGW, lane, off);
            for (int j = 0; j < 2; ++j) conv_mat(a.in[IN_WO_B] + (size_t)j * DM * DM, DM, DM, 0, DM, (bf16*)(ws + W_O_B + j * 2 * MiB), 0, nullptr, 1.f, scr, gw, NGW, lane, off);
        }
        for (int l = 0; l < NLAYER; ++l) {
            conv_mat(a.in[IN_WUP] + (size_t)l * DM * NUP, NUP, DM, 0, NUP, (bf16*)(ws + W_UP + l * 11 * MiB), 1, gains + (l * 4 + 2) * DM, 1.f, scr, gw, NGW, lane, off);
            conv_mat(a.in[IN_WDOWN] + (size_t)l * DFF * DM, DM, DFF, 0, DM, (bf16*)(ws + W_DN + l * 11 * MiB / 2), 0, nullptr, 1.f, scr, gw, NGW, lane, off);
        }
        const int gt = bx * 512 + tid;
        if (gt < SEQ * 8) { const int pos = gt >> 3, i = gt & 7; float sn, cs; sincos_f64((float)pos * a.invf[i], sn, cs);
            ((float*)(ws + WS_ROPE))[gt] = cs; ((float*)(ws + WS_ROPE))[SEQ * 8 + gt] = sn; }
        if (gt < 16 * DM) { const int hd = gt >> 10, k = gt & 1023; ((float*)(ws + WS_WFT))[gt] = a.in[IN_WKVF][(size_t)k * 2064 + 2048 + hd] * a.in[IN_KVNORM][k]; }
        row_phase<0>(a.in[IN_X], nullptr, h, xn, (bf16*)(ws + G_XP1), (bf16*)(ws + G_XP2), true, true, false, (const LAS float*)lds, nullptr, nullptr, gw, NGW, lane);
    PH_END(0)
    run_layer<0>(a, lds, grid);
    run_layer<1>(a, lds, grid);
    run_layer<2>(a, lds, grid);
    run_layer<3>(a, lds, grid);
}

#ifndef MK_SINGLE
#define MK_SINGLE 1
#endif
extern "C" void kernel_launch(void* const* d_in, const int* in_sizes, int n_in, void* d_out, int out_size, void* d_ws, size_t ws_size, hipStream_t stream) {
    static int grid = 0;
    if (grid == 0) {
        if (n_in != 13 || out_size != MROWS * DM || ws_size < WS_END) { fprintf(stderr, "kernel_launch: unexpected shapes (n_in %d, out %d, ws %zu)\n", n_in, out_size, ws_size); grid = -1; return; }
        int dev = 0, cus = 0, per_cu = 0;
        hipGetDevice(&dev); hipDeviceGetAttribute(&cus, hipDeviceAttributeMultiprocessorCount, dev);
        if (hipFuncSetAttribute((const void*)yoco_fwd, hipFuncAttributeMaxDynamicSharedMemorySize, LDS_BYTES) != hipSuccess) { fprintf(stderr, "kernel_launch: hipFuncSetAttribute failed\n"); grid = -1; return; }
        hipOccupancyMaxActiveBlocksPerMultiprocessor(&per_cu, (const void*)yoco_fwd, 512, LDS_BYTES);
        if (per_cu < 1) { fprintf(stderr, "kernel_launch: occupancy query says %d\n", per_cu); per_cu = 1; }
        (void)hipGetLastError();
        grid = cus * 1;
        fprintf(stderr, "kernel_launch: grid %d (per_cu %d)\n", grid, per_cu);
    }
    if (grid < 0) return;
    Args a{};
    for (int i = 0; i < 13; ++i) a.in[i] = (const float*)d_in[i];
    a.out = (float*)d_out; a.ws = (unsigned char*)d_ws;
    for (int i = 0; i < 8; ++i) a.invf[i] = powf(500000.0f, -(float)(2 * i) / 16.0f);
#if MK_SINGLE
    a.ph_lo = 0; a.ph_hi = NPHASE;
    void* args[] = {&a};
    hipError_t e = hipLaunchCooperativeKernel((const void*)yoco_fwd, dim3(grid), dim3(512), args, LDS_BYTES, stream);
    if (e != hipSuccess) fprintf(stderr, "cooperative launch failed: %s (grid %d)\n", hipGetErrorString(e), grid);
#else
    for (int ph = 0; ph < NPHASE; ++ph) {
        if (phase_noop(ph)) continue;
        a.ph_lo = ph; a.ph_hi = ph + 1;
        hipLaunchKernelGGL(yoco_fwd, dim3(grid), dim3(512), LDS_BYTES, stream, a);
    }
#endif
}
```

```cpp
#include <hip/hip_runtime.h>
#include <hip/hip_cooperative_groups.h>
#include <cstdio>
#include <cstdint>
#include <cmath>
namespace cg = cooperative_groups;
namespace pg8 {
#define PG8_LAS __attribute__((address_space(3)))
typedef unsigned short bf16_t;
typedef short bf16x8 __attribute__((ext_vector_type(8)));
typedef float f32x4 __attribute__((ext_vector_type(4)));
typedef unsigned u32x4 __attribute__((ext_vector_type(4)));
constexpr int BM = 256, BK = 64, HALF = 128, HTB = HALF * BK * 2  , STAGE_BYTES = 8 * HTB, NXCD = 8, WGM = 8;

__host__ __device__ __forceinline__ int lds_byte(int r, int c) { const int st = (r >> 4) * 2 + (c >> 5), rr = r & 15, cc = c & 31, ob = rr * 64 + cc * 2; return st * 1024 + (ob ^ (((ob >> 9) & 1) << 5)); }
__host__ __device__ __forceinline__ void stage_rc(int b, int& R, int& C) { const int st = b / 1024, sb = b % 1024, swz = sb ^ (((sb >> 9) & 1) << 5); R = (st >> 1) * 16 + swz / 64; C = (st & 1) * 32 + (swz % 64) / 2; }
__host__ __device__ __forceinline__ int perm32(int rho) { const int n = rho >> 4, i = rho & 15; return 8 * (i >> 2) + 4 * n + (i & 3); }

struct Unit { int pm, pn; };
struct Gemm { const bf16_t* A; const bf16_t* Bt; int M, N, K; };

struct StaticOrder {
    int nM, nN, nwg, G, c, reps;
    __host__ __device__ void init(int M, int N, int G_, int c_) { nM = M / BM; nN = N / BM; nwg = nM * nN; G = G_; c = c_; reps = 1; }
    __host__ __device__ bool next(int i, Unit& u) const {
        if (reps > 1) { const int nmine = (c < nwg) ? (nwg - c + G - 1) / G : 0; if (i >= reps * nmine) return false; i = i % nmine; }
        const long L = (long)i * G + c; if (L >= nwg) return false;
        int wgid = (int)L; { const int q = nwg / NXCD, r = nwg % NXCD, xcd = wgid % NXCD, off = wgid / NXCD; wgid = (xcd < r ? xcd * (q + 1) : r * (q + 1) + (xcd - r) * q) + off; }
        const int nig = WGM * nN, gid = wgid / nig, fm = gid * WGM, gsz = (nM - fm) < WGM ? (nM - fm) : WGM;
        u.pm = fm + ((wgid % nig) % gsz); u.pn = (wgid % nig) / gsz; return true;
    }
    __device__ __forceinline__ void a_ready(const Unit&) const {}
    __device__ __forceinline__ void done(const Unit&) const {}
};

__device__ __forceinline__ unsigned cvt_pk_bf16(float lo, float hi) { unsigned r; asm volatile("v_cvt_pk_bf16_f32 %0, %1, %2" : "=v"(r) : "v"(lo), "v"(hi)); return r; }
typedef float f32x2 __attribute__((ext_vector_type(2)));
__device__ __forceinline__ f32x2 gelu_pk(f32x2 v) {
    const f32x2 av = __builtin_elementwise_abs(v), d = av * 0.2316418882f + 1.0f;
    f32x2 t; t.x = __builtin_amdgcn_rcpf(d.x); t.y = __builtin_amdgcn_rcpf(d.y);
    f32x2 q = t * 0.5307027145f + (-0.7265760135f); q = q * t + 0.7107068705f; q = q * t + (-0.142248368f); q = q * t + 0.127414796f; q = q * t;
    const f32x2 s = (v * v) * (-0.72134752044f);
    f32x2 e; e.x = __builtin_amdgcn_exp2f(s.x); e.y = __builtin_amdgcn_exp2f(s.y);
    const f32x2 m = v * (q * e), r = v - m;
    f32x2 o; o.x = v.x < 0.f ? m.x : r.x; o.y = v.y < 0.f ? m.y : r.y; return o;
}

template <int ACT  > struct EpiBf16 {
    static constexpr bool PERM = true, AFTER_DRAIN = false; static_assert(ACT == 0 || ACT == 1, "EpiBf16: ACT is 0 (none) or 1 (gelu_pk)");
    bf16_t* O; int ldc; const float* bias; int split_cols; size_t split_stride; float scale0;
    __device__ __forceinline__ void operator()(const f32x4 (&acc)[2][2][4][2], const Unit& u, int wr, int wc, int fr, int fq) const {
        const int row0 = u.pm * BM + wr * 64 + fr; int colt = u.pn * BM; bf16_t* base = O;
        float sc = 1.f; if (split_cols) { const int t = colt / split_cols; base += (size_t)t * split_stride; colt -= t * split_cols; if (t == 0) sc = scale0; }
        const int col0 = colt + wc * 32 + 8 * fq, bcol0 = u.pn * BM + wc * 32 + 8 * fq;
        f32x4 bv[2][2];
#pragma unroll
        for (int bj = 0; bj < 2; ++bj)
#pragma unroll
            for (int n = 0; n < 2; ++n) bv[bj][n] = bias ? *(const f32x4*)(bias + bcol0 + bj * HALF + 4 * n) : (f32x4){0.f, 0.f, 0.f, 0.f};
#pragma unroll
        for (int ai = 0; ai < 2; ++ai)
#pragma unroll
            for (int m = 0; m < 4; ++m) { bf16_t* rowp = base + (size_t)(row0 + ai * HALF + m * 16) * ldc + col0;
#pragma unroll
                for (int bj = 0; bj < 2; ++bj) { f32x4 v0 = acc[ai][bj][m][0] + bv[bj][0], v1 = acc[ai][bj][m][1] + bv[bj][1];
                    if (ACT == 1) { f32x2 a = gelu_pk((f32x2){v0[0], v0[1]}), b = gelu_pk((f32x2){v0[2], v0[3]}), c = gelu_pk((f32x2){v1[0], v1[1]}), d = gelu_pk((f32x2){v1[2], v1[3]});
                        v0 = (f32x4){a.x, a.y, b.x, b.y}; v1 = (f32x4){c.x, c.y, d.x, d.y}; }
                    v0 = v0 * sc; v1 = v1 * sc; u32x4 w; w.x = cvt_pk_bf16(v0[0], v0[1]); w.y = cvt_pk_bf16(v0[2], v0[3]); w.z = cvt_pk_bf16(v1[0], v1[1]); w.w = cvt_pk_bf16(v1[2], v1[3]);
                    *(u32x4*)(rowp + bj * HALF) = w; } }
    }
};
template <class Epi, class Sched, bool ALIGN_EPI = false, bool SP2 = false>
__device__ __forceinline__ void gemm_phase(PG8_LAS unsigned char* lds, const Gemm g, const Sched& S, const Epi& E) {
    const int tid = threadIdx.x, wid = __builtin_amdgcn_readfirstlane(tid >> 6), lane = tid & 63, wr = wid >> 2, wc = wid & 3, fr = lane & 15, fq = lane >> 4;
    const int K = g.K, nt = K / BK;
    unsigned voffA[2], voffB[2];
#pragma unroll
    for (int i = 0; i < 2; ++i) { int R, C; stage_rc(tid * 16 + i * 8192, R, C); const int Rb = Epi::PERM ? ((R & ~31) + perm32(R & 31)) : R;
        voffA[i] = (unsigned)(R * K + C) * 2u; voffB[i] = (unsigned)(Rb * K + C) * 2u; }
    const size_t kstep = (size_t)(BK * 2);
    const size_t hstep = (size_t)HALF * K * 2;
    const size_t tstep = 2 * hstep;
    const unsigned ldsw = (unsigned)wid * 1024u;
    const int aoff = lds_byte(wr * 64 + fr, fq * 8), boff = lds_byte(wc * 32 + fr, fq * 8);
#define PG8_SA(b, h) (((b) * 2 + (h)) * HTB)
#define PG8_SB(b, h) ((4 + (b) * 2 + (h)) * HTB)
#define PG8_STAGE(bufoff, gbase, voff) do { _Pragma("unroll") for (int _i = 0; _i < 2; ++_i) \
        __builtin_amdgcn_global_load_lds((const unsigned*)((const char*)(gbase) + (voff)[_i]), (PG8_LAS unsigned*)(lds + (bufoff) + ldsw + _i * 8192), 16, 0, 0); } while (0)
#define PG8_LDA(dst, b, h) do { _Pragma("unroll") for (int m = 0; m < 4; ++m) _Pragma("unroll") for (int k = 0; k < 2; ++k) dst[m][k] = *(const PG8_LAS bf16x8*)(lds + PG8_SA(b, h) + aoff + m * 2048 + k * 1024); } while (0)
#define PG8_LDB(dst, b, h) do { _Pragma("unroll") for (int n = 0; n < 2; ++n) _Pragma("unroll") for (int k = 0; k < 2; ++k) dst[n][k] = *(const PG8_LAS bf16x8*)(lds + PG8_SB(b, h) + boff + n * 2048 + k * 1024); } while (0)
#define PG8_MMA(ai, bj, At, Bt) do { __builtin_amdgcn_s_setprio(1); _Pragma("unroll") for (int m = 0; m < 4; ++m) _Pragma("unroll") for (int n = 0; n < 2; ++n) _Pragma("unroll") for (int k = 0; k < 2; ++k) \
        acc[ai][bj][m][n] = __builtin_amdgcn_mfma_f32_16x16x32_bf16(Bt[n][k], At[m][k], acc[ai][bj][m][n], 0, 0, 0); __builtin_amdgcn_s_setprio(0); } while (0)
#define PG8_WAIT_V(n) asm volatile("s_waitcnt vmcnt(" #n ")" ::: "memory")
#define PG8_WAIT_L(n) asm volatile("s_waitcnt lgkmcnt(" #n ")" ::: "memory")
#define PG8_BAR __builtin_amdgcn_s_barrier()
#define PG8_SCHED __builtin_amdgcn_sched_barrier(0)
    Unit cur, nxt; int ui = 0;
    if (!S.next(0, cur)) return;
    f32x4 acc[2][2][4][2];
#pragma unroll
    for (int a = 0; a < 2; ++a)
#pragma unroll
        for (int b = 0; b < 2; ++b)
#pragma unroll
            for (int m = 0; m < 4; ++m)
#pragma unroll
                for (int n = 0; n < 2; ++n) acc[a][b][m][n] = (f32x4){0.f, 0.f, 0.f, 0.f};
    bf16x8 At[4][2], B0[2][2], B1[2][2];
    const char* cA = (const char*)g.A + (size_t)cur.pm * tstep; const char* cB = (const char*)g.Bt + (size_t)cur.pn * tstep;
    S.a_ready(cur);
    if constexpr (SP2) {
        PG8_STAGE(PG8_SB(0, 0), cB, voffB); PG8_STAGE(PG8_SB(0, 1), cB + hstep, voffB); PG8_STAGE(PG8_SA(0, 0), cA, voffA); PG8_STAGE(PG8_SA(0, 1), cA + hstep, voffA);
        if (wr == 1) PG8_BAR;
        PG8_WAIT_V(2); PG8_BAR;
        PG8_STAGE(PG8_SB(1, 0), cB + kstep, voffB); PG8_STAGE(PG8_SA(1, 0), cA + kstep, voffA); PG8_STAGE(PG8_SB(1, 1), cB + hstep + kstep, voffB);
        PG8_WAIT_V(6); PG8_BAR;
    } else {
        PG8_STAGE(PG8_SB(0, 0), cB, voffB); PG8_STAGE(PG8_SA(0, 0), cA, voffA); PG8_STAGE(PG8_SB(0, 1), cB + hstep, voffB); PG8_STAGE(PG8_SA(0, 1), cA + hstep, voffA);
        if (wr == 1) PG8_BAR;
        PG8_WAIT_V(4); PG8_BAR;
        PG8_STAGE(PG8_SB(1, 0), cB + kstep, voffB); PG8_STAGE(PG8_SA(1, 0), cA + kstep, voffA); PG8_STAGE(PG8_SB(1, 1), cB + hstep + kstep, voffB);
        PG8_WAIT_V(6); PG8_BAR;
    }
    for (;;) {
        const bool has_next = S.next(ui + 1, nxt);
        const char* nA = has_next ? (const char*)g.A + (size_t)nxt.pm * tstep : cA; const char* nB = has_next ? (const char*)g.Bt + (size_t)nxt.pn * tstep : cB;
        for (int t = 0; t < nt; t += 2) {
            const bool last = (t == nt - 2);
            const char* a1 = cA + (size_t)(t + 1) * kstep;
            const char* a2 = last ? nA : cA + (size_t)(t + 2) * kstep; const char* b2 = last ? nB : cB + (size_t)(t + 2) * kstep;
            const char* a3 = a2 + kstep; const char* b3 = b2 + kstep;
            if (last && has_next) S.a_ready(nxt);
            if constexpr (SP2) {
            PG8_LDB(B0, 0, 0); PG8_LDB(B1, 0, 1); PG8_SCHED; PG8_LDA(At, 0, 0); PG8_STAGE(PG8_SA(1, 1), a1 + hstep, voffA);
            PG8_WAIT_V(8); PG8_WAIT_L(0); PG8_BAR; PG8_MMA(0, 0, At, B0); PG8_MMA(0, 1, At, B1); PG8_BAR; PG8_SCHED;
            PG8_LDA(At, 0, 1); PG8_STAGE(PG8_SB(0, 0), b2, voffB); PG8_STAGE(PG8_SB(0, 1), b2 + hstep, voffB); PG8_STAGE(PG8_SA(0, 0), a2, voffA);
            PG8_WAIT_V(8); PG8_WAIT_L(0); PG8_BAR; PG8_MMA(1, 0, At, B0); PG8_MMA(1, 1, At, B1); PG8_BAR; PG8_SCHED;
            PG8_LDB(B0, 1, 0); PG8_LDB(B1, 1, 1); PG8_SCHED; PG8_LDA(At, 1, 0); PG8_STAGE(PG8_SA(0, 1), a2 + hstep, voffA);
            PG8_WAIT_V(8); PG8_WAIT_L(0); PG8_BAR; PG8_MMA(0, 0, At, B0); PG8_MMA(0, 1, At, B1); PG8_BAR; PG8_SCHED;
            PG8_LDA(At, 1, 1); PG8_STAGE(PG8_SB(1, 0), b3, voffB); PG8_STAGE(PG8_SB(1, 1), b3 + hstep, voffB); PG8_STAGE(PG8_SA(1, 0), a3, voffA);
            PG8_WAIT_V(8); PG8_WAIT_L(0); PG8_BAR; PG8_MMA(1, 0, At, B0); PG8_MMA(1, 1, At, B1); PG8_BAR; PG8_SCHED;
            } else {
            PG8_LDB(B0, 0, 0); PG8_SCHED; PG8_LDA(At, 0, 0); PG8_STAGE(PG8_SA(1, 1), a1 + hstep, voffA);
            PG8_WAIT_L(8); PG8_BAR; PG8_WAIT_L(0); PG8_MMA(0, 0, At, B0); PG8_BAR; PG8_SCHED;
            PG8_LDB(B1, 0, 1); PG8_STAGE(PG8_SB(0, 0), b2, voffB);
            PG8_BAR; PG8_WAIT_L(0); PG8_MMA(0, 1, At, B1); PG8_BAR;
            PG8_LDA(At, 0, 1); PG8_STAGE(PG8_SA(0, 0), a2, voffA);
            PG8_BAR; PG8_WAIT_L(0); PG8_MMA(1, 0, At, B0); PG8_BAR; PG8_SCHED;
            PG8_STAGE(PG8_SB(0, 1), b2 + hstep, voffB);
            PG8_WAIT_V(6); PG8_BAR; PG8_MMA(1, 1, At, B1); PG8_BAR;
            PG8_LDB(B0, 1, 0); PG8_SCHED; PG8_LDA(At, 1, 0); PG8_STAGE(PG8_SA(0, 1), a2 + hstep, voffA);
            PG8_WAIT_L(8); PG8_BAR; PG8_WAIT_L(0); PG8_MMA(0, 0, At, B0); PG8_BAR; PG8_SCHED;
            PG8_LDB(B1, 1, 1); PG8_STAGE(PG8_SB(1, 0), b3, voffB);
            PG8_BAR; PG8_WAIT_L(0); PG8_MMA(0, 1, At, B1); PG8_BAR;
            PG8_LDA(At, 1, 1); PG8_STAGE(PG8_SA(1, 0), a3, voffA);
            PG8_BAR; PG8_WAIT_L(0); PG8_MMA(1, 0, At, B0); PG8_BAR; PG8_SCHED;
            PG8_STAGE(PG8_SB(1, 1), b3 + hstep, voffB);
            PG8_WAIT_V(6); PG8_BAR; PG8_MMA(1, 1, At, B1); PG8_BAR;
            }
        }
        if constexpr (ALIGN_EPI) { if (wr == 0) PG8_BAR; }
        if constexpr (!Epi::AFTER_DRAIN) { E(acc, cur, wr, wc, fr, fq); S.done(cur); }
        if (!has_next) break;
#pragma unroll
        for (int a = 0; a < 2; ++a)
#pragma unroll
            for (int b = 0; b < 2; ++b)
#pragma unroll
                for (int m = 0; m < 4; ++m)
#pragma unroll
                    for (int n = 0; n < 2; ++n) acc[a][b][m][n] = (f32x4){0.f, 0.f, 0.f, 0.f};
        cur = nxt; cA = nA; cB = nB; ++ui;
        if constexpr (ALIGN_EPI) { if (wr == 1) PG8_BAR; }
    }
    PG8_WAIT_V(0);
    if constexpr (!ALIGN_EPI) { if (wr == 0) PG8_BAR; }
    PG8_BAR;
    if constexpr (Epi::AFTER_DRAIN) { E.fused(acc, cur, wr, wc, fr, fq, lds, wid, lane); S.done(cur); }
#undef PG8_SA
#undef PG8_SB
#undef PG8_STAGE
#undef PG8_LDA
#undef PG8_LDB
#undef PG8_MMA
#undef PG8_WAIT_V
#undef PG8_WAIT_L
#undef PG8_BAR
#undef PG8_SCHED
}
}

#define LAS __attribute__((address_space(3)))
typedef unsigned short bf16;
typedef short bf16x8 __attribute__((ext_vector_type(8)));
typedef short s16x4 __attribute__((ext_vector_type(4)));
typedef float f32x4 __attribute__((ext_vector_type(4)));
typedef float f32x16 __attribute__((ext_vector_type(16)));
typedef unsigned u32x4 __attribute__((ext_vector_type(4)));
typedef unsigned u32x2 __attribute__((ext_vector_type(2)));

constexpr int BATCH = 8, SEQ = 2048, DM = 1024, MROWS = BATCH * SEQ;
constexpr int AW = 768, DFF = 2816, NUP = 2 * DFF, NLAYER = 4;
constexpr float RMS_EPS = 1e-6f;
constexpr float LOG2E = 1.4426950408889634f;
constexpr float QSCALE = 0.125f * 1.4426950408889634f;
constexpr size_t MiB = 1u << 20;
constexpr size_t WS_ROPE = 64 * 1024;
constexpr size_t WS_WFT = 256 * 1024;
constexpr size_t WS_W = 1 * MiB;
constexpr size_t W_QK_A = WS_W, W_V_A = WS_W + 6 * MiB, W_O_A = WS_W + 9 * MiB, W_QK_B = WS_W + 12 * MiB, W_V_B = WS_W + 16 * MiB,
                 W_Q_B1 = WS_W + 18 * MiB, W_O_B = WS_W + 20 * MiB, W_UP = WS_W + 24 * MiB, W_DN = WS_W + 68 * MiB;
constexpr size_t WS_C2 = 91 * MiB, WS_FLOG = 92 * MiB, WS_LSE = 93 * MiB;
constexpr size_t WS_XN = 94 * MiB;
constexpr size_t WS_F = 126 * MiB;
constexpr size_t WS_G = 190 * MiB;
constexpr size_t G_QK_A = WS_G, G_VT_A = WS_G + 48 * MiB, G_O_A = WS_G + 72 * MiB, G_XP1 = WS_G + 96 * MiB, G_XP2 = WS_G + 128 * MiB;
constexpr size_t G_Q_B = WS_G, G_O_B = WS_G + 32 * MiB, G_K_B = WS_G + 96 * MiB, G_VT_B = WS_G + 128 * MiB;
constexpr size_t G_U = WS_G;
constexpr size_t WS_END = 352 * MiB;
constexpr int LDS_BYTES = 147456;
constexpr int LDS_MISC = 131072 + 320;
constexpr size_t WS_BAR = 16384;
constexpr int NPHASE = 1 + 9 * NLAYER;

__device__ __forceinline__ unsigned pk2(float lo, float hi) {
    typedef float f2 __attribute__((ext_vector_type(2))); typedef __bf16 b2 __attribute__((ext_vector_type(2)));
    f2 v = {lo, hi}; b2 b = __builtin_convertvector(v, b2); return __builtin_bit_cast(unsigned, b);
}
__device__ __forceinline__ float bf_lo(unsigned w) { return __uint_as_float(w << 16); }
__device__ __forceinline__ float bf_hi(unsigned w) { return __uint_as_float(w & 0xffff0000u); }
__device__ __forceinline__ float wave_sum(float v) {
#pragma unroll
    for (int o = 1; o < 64; o <<= 1) v += __shfl_xor(v, o);
    return v;
}
#define LDS_WAIT() asm volatile("s_waitcnt lgkmcnt(0)" ::: "memory")

namespace pg8 {
struct EpiF32 {
    static constexpr bool PERM = false, AFTER_DRAIN = false;
    float* O; int ldc;
    __device__ __forceinline__ void operator()(const f32x4 (&acc)[2][2][4][2], const Unit& u, int wr, int wc, int fr, int fq) const {
        const int row0 = u.pm * BM + wr * 64 + fr, col0 = u.pn * BM + wc * 32 + 4 * fq;
#pragma unroll
        for (int ai = 0; ai < 2; ++ai)
#pragma unroll
            for (int m = 0; m < 4; ++m) { float* rowp = O + (size_t)(row0 + ai * HALF + m * 16) * ldc + col0;
#pragma unroll
                for (int bj = 0; bj < 2; ++bj)
#pragma unroll
                    for (int n = 0; n < 2; ++n) *(f32x4*)(rowp + bj * HALF + n * 16) = acc[ai][bj][m][n]; }
    }
};
template <int CTRL> __device__ __forceinline__ float dppf(float old, float src) {
    return __int_as_float(__builtin_amdgcn_update_dpp(__float_as_int(old), __float_as_int(src), CTRL, 0xf, 0xf, false));
}
__device__ __forceinline__ float gelu_tanh(float x) {
    const float z = 0.7978845608028654f * (x + 0.044715f * x * x * x);
    const float e = __builtin_amdgcn_exp2f(-2.0f * 1.4426950408889634f * z);
    return x * __builtin_amdgcn_rcpf(1.0f + e);
}
struct EpiConvGlu {
    static constexpr bool PERM = true, AFTER_DRAIN = false;
    bf16_t* U; float* side; const float* cw; const float* cb;
    __device__ __forceinline__ void operator()(const f32x4 (&acc)[2][2][4][2], const Unit& u, int wr, int wc, int fr, int fq) const {
        const int chb = u.pn * HALF + wc * 32 + 8 * fq;
#pragma unroll
        for (int n = 0; n < 2; ++n) {
            const int ch = chb + 4 * n;
            const f32x4 wg0 = *(const f32x4*)(cw + ch), wg1 = *(const f32x4*)(cw + NUP + ch), wg2 = *(const f32x4*)(cw + 2 * NUP + ch), bg = *(const f32x4*)(cb + ch);
            const f32x4 wv0 = *(const f32x4*)(cw + DFF + ch), wv1 = *(const f32x4*)(cw + NUP + DFF + ch), wv2 = *(const f32x4*)(cw + 2 * NUP + DFF + ch), bv = *(const f32x4*)(cb + DFF + ch);
#pragma unroll
            for (int ai = 0; ai < 2; ++ai) {
                const int chunk = u.pm * 4 + ai * 2 + wr, rowbase = u.pm * BM + ai * HALF + wr * 64;
#pragma unroll
                for (int m = 0; m < 4; ++m) {
                    const f32x4 xg = acc[ai][0][m][n], xv = acc[ai][1][m][n];
                    if (m == 0 && fr < 2) { float* sp = side + (size_t)(chunk * 4 + fr) * NUP + ch; *(f32x4*)sp = xg; *(f32x4*)(sp + DFF) = xv; }
                    if (m == 3 && fr >= 14) { float* sp = side + (size_t)(chunk * 4 + fr - 12) * NUP + ch; *(f32x4*)sp = xg; *(f32x4*)(sp + DFF) = xv; }
                    f32x4 pg = (f32x4){0.f, 0.f, 0.f, 0.f}, pv = pg;
                    if (m > 0) { pg = acc[ai][0][m - 1][n]; pv = acc[ai][1][m - 1][n]; }
                    f32x4 g1, g2, v1, v2;
#pragma unroll
                    for (int e = 0; e < 4; ++e) {
                        g1[e] = dppf<0x111>(dppf<0x121>(0.f, pg[e]), xg[e]); g2[e] = dppf<0x112>(dppf<0x122>(0.f, pg[e]), xg[e]);
                        v1[e] = dppf<0x111>(dppf<0x121>(0.f, pv[e]), xv[e]); v2[e] = dppf<0x112>(dppf<0x122>(0.f, pv[e]), xv[e]);
                    }
                    const f32x4 cg = wg0 * g2 + wg1 * g1 + wg2 * xg + bg, cv = wv0 * v2 + wv1 * v1 + wv2 * xv + bv;
                    f32x4 o;
#pragma unroll
                    for (int e = 0; e < 4; ++e) o[e] = gelu_tanh(cg[e]) * cv[e];
                    if (!(m == 0 && fr < 2)) { u32x2 w; w.x = pk2(o[0], o[1]); w.y = pk2(o[2], o[3]); *(u32x2*)(U + (size_t)(rowbase + m * 16 + fr) * DFF + ch) = w; }
                }
            }
        }
    }
};
}

__device__ __forceinline__ void wt_item(const float* W, int ldw, int K, int k0, int ncol0, bf16* WT, int out_row0, const float* gain, float scale, LAS float* scr, int lane) {
#pragma unroll 8
    for (int i = 0; i < 32; ++i) { const int kk = 2 * i + (lane >> 5); const float g = gain ? gain[k0 + kk] * scale : scale;
        scr[kk * 33 + (lane & 31)] = W[(size_t)(k0 + kk) * ldw + ncol0 + (lane & 31)] * g; }
    LDS_WAIT();
    const int c = lane & 7;
#pragma unroll
    for (int j = 0; j < 4; ++j) { const int n = (lane >> 3) + 8 * j; const LAS float* s = scr + (8 * c) * 33 + n;
        u32x4 o; o.x = pk2(s[0 * 33], s[1 * 33]); o.y = pk2(s[2 * 33], s[3 * 33]); o.z = pk2(s[4 * 33], s[5 * 33]); o.w = pk2(s[6 * 33], s[7 * 33]);
        *(u32x4*)(WT + (size_t)(out_row0 + n) * K + k0 + 8 * c) = o; }
    LDS_WAIT();
}
__device__ __forceinline__ void conv_mat(const float* W, int ldw, int K, int col0, int ncols, bf16* WT, int mode, const float* gain, float scale,
                                         LAS float* scr, int gw, int NGW, int lane, int& off) {
    const int nnb = ncols / 32, nitems = (K / 64) * nnb;
    for (int it = (gw + NGW - off) % NGW; it < nitems; it += NGW) {
        const int kb = it / nnb, nb = it % nnb, n0 = 32 * nb;
        int out_row0 = n0;
        if (mode == 1) { const int bj = n0 / DFF, ch0 = n0 % DFF; out_row0 = 256 * (ch0 / 128) + 128 * bj + (ch0 % 128); }
        wt_item(W, ldw, K, 64 * kb, col0 + n0, WT, out_row0, gain, scale, scr, lane);
    }
    off = (off + nitems) % NGW;
}

__device__ __forceinline__ void sincos_f64(float ang, float& sn, float& cs) {
    const double x = (double)ang; const double k = __builtin_rint(x * 0.63661977236758134308);
    double r = __builtin_fma(-k, 1.57079632679489655800, x); r = __builtin_fma(-k, 6.12323399573676603587e-17, r);
    const double r2 = r * r;
    double s = 1.6059043836821613e-10; s = s * r2 - 2.5052108385441720e-08; s = s * r2 + 2.7557319223985893e-06; s = s * r2 - 1.9841269841269841e-04;
    s = s * r2 + 8.3333333333333332e-03; s = s * r2 - 1.6666666666666666e-01; s = s * r2 * r + r;
    double c = -1.1470745597729725e-11; c = c * r2 + 2.0876756987868100e-09; c = c * r2 - 2.7557319223985888e-07; c = c * r2 + 2.4801587301587302e-05;
    c = c * r2 - 1.3888888888888889e-03; c = c * r2 + 4.1666666666666664e-02; c = c * r2 - 0.5; c = c * r2 + 1.0;
    const int q = ((int)k) & 3;
    const double ss = (q == 0) ? s : (q == 1) ? c : (q == 2) ? -s : -c;
    const double cc = (q == 0) ? c : (q == 1) ? -s : (q == 2) ? -c : s;
    sn = (float)ss; cs = (float)cc;
}

template <int MODE>
__device__ __forceinline__ void row_phase(const float* src, const float* gain, float* h, bf16* xn, bf16* xp1, bf16* xp2, bool want_xn, bool want_perm,
                                          bool want_forget, const LAS float* wft, const float* bfg, float* flog, int gw, int NGW, int lane) {
    for (int m = gw; m < MROWS; m += NGW) {
        f32x4 v[4]; float ss = 0.f;
#pragma unroll
        for (int j = 0; j < 4; ++j) {
            if (MODE == 1) { const u32x2 w = *(const u32x2*)((const bf16*)src + (size_t)m * DM + 4 * lane + 256 * j); v[j] = (f32x4){bf_lo(w.x), bf_hi(w.x), bf_lo(w.y), bf_hi(w.y)}; }
            else v[j] = *(const f32x4*)(src + (size_t)m * DM + 4 * lane + 256 * j);
            ss += (v[j].x * v[j].x + v[j].y * v[j].y) + (v[j].z * v[j].z + v[j].w * v[j].w); }
        if (MODE == 1) {
            const float rs = 1.0f / sqrtf(wave_sum(ss) * (1.0f / DM) + RMS_EPS); ss = 0.f;
#pragma unroll
            for (int j = 0; j < 4; ++j) { const f32x4 g = *(const f32x4*)(gain + 4 * lane + 256 * j); const f32x4 ho = *(const f32x4*)(h + (size_t)m * DM + 4 * lane + 256 * j);
                v[j] = ho + v[j] * rs * g; ss += (v[j].x * v[j].x + v[j].y * v[j].y) + (v[j].z * v[j].z + v[j].w * v[j].w); }
        }
#pragma unroll
        for (int j = 0; j < 4; ++j) *(f32x4*)(h + (size_t)m * DM + 4 * lane + 256 * j) = v[j];
        if (want_xn) {
            const float rs2 = 1.0f / sqrtf(wave_sum(ss) * (1.0f / DM) + RMS_EPS);
#pragma unroll
            for (int j = 0; j < 4; ++j) v[j] = v[j] * rs2;
            u32x2 w[4];
#pragma unroll
            for (int j = 0; j < 4; ++j) { w[j].x = pk2(v[j].x, v[j].y); w[j].y = pk2(v[j].z, v[j].w); *(u32x2*)(xn + (size_t)m * DM + 4 * lane + 256 * j) = w[j]; }
            if (want_perm) {
                const int b = m / SEQ, t = m % SEQ;
                const size_t m1 = (size_t)b * SEQ + (t & 3) * 512 + (t >> 2), m2 = (size_t)b * SEQ + (t & 15) * 128 + (t >> 4);
#pragma unroll
                for (int j = 0; j < 4; ++j) { *(u32x2*)(xp1 + m1 * DM + 4 * lane + 256 * j) = w[j]; *(u32x2*)(xp2 + m2 * DM + 4 * lane + 256 * j) = w[j]; }
            }
            if (want_forget) {
                float mine = 0.f;
#pragma unroll 4
                for (int hd = 0; hd < 16; ++hd) { float a = 0.f;
#pragma unroll
                    for (int j = 0; j < 4; ++j) { const f32x4 wv = *(const LAS f32x4*)(wft + hd * DM + 4 * lane + 256 * j); a += (v[j].x * wv.x + v[j].y * wv.y) + (v[j].z * wv.z + v[j].w * wv.w); }
                    a = wave_sum(a); if (lane == hd) mine = a; }
                if (lane < 16) flog[(size_t)m * 16 + lane] = mine + bfg[lane];
            }
        }
    }
}

__device__ __forceinline__ float log_sigmoid(float x) { return fminf(x, 0.f) - logf(1.0f + expf(-fabsf(x))); }
__device__ __forceinline__ void scan_unit(const float* flog, float* c2, int bh, int lane) {
    const int b = bh >> 4, hd = bh & 15; const float* fp = flog + ((size_t)b * SEQ + 32 * lane) * 16 + hd;
    float tot = 0.f;
    for (int i = 0; i < 32; ++i) tot += log_sigmoid(fp[i * 16]);
    float inc = tot;
#pragma unroll
    for (int o = 1; o < 64; o <<= 1) { const float t = __shfl_up(inc, o); if (lane >= o) inc += t; }
    float run = inc - tot;
    float* cp = c2 + (size_t)bh * SEQ + 32 * lane;
    for (int i = 0; i < 32; ++i) { run += log_sigmoid(fp[i * 16]); cp[i] = run * LOG2E; }
}

struct AttnHalf {
    const bf16* Q; const bf16* K; const bf16* VT; bf16* O; float* lse; const float* cq;
    int q_stride, k_stride, vt_pitch, o_stride, lse_stride;
    int q0, kv_begin, nback, pos0, pos_step;
};
constexpr int AT_PITCH = 144, AT_K = 0, AT_V = 9216, AT_CK = 18432, AT_BUF = 18688, AT_HALF = 2 * AT_BUF;
__device__ __forceinline__ int crow(int r, int hi) { return (r & 3) + 8 * (r >> 2) + 4 * hi; }
__device__ __forceinline__ void rope16v(u32x4& a, u32x4& b, const f32x4 c0, const f32x4 c1, const f32x4 s0, const f32x4 s1) {
#define RC_(k) ((k) < 4 ? c0[(k) & 3] : c1[(k) & 3])
#define RS_(k) ((k) < 4 ? s0[(k) & 3] : s1[(k) & 3])
    u32x4 oa, ob;
#pragma unroll
    for (int i = 0; i < 4; ++i) {
        const float x1l = bf_lo(a[i]), x1h = bf_hi(a[i]), x2l = bf_lo(b[i]), x2h = bf_hi(b[i]);
        oa[i] = pk2(x1l * RC_(2 * i) - x2l * RS_(2 * i), x1h * RC_(2 * i + 1) - x2h * RS_(2 * i + 1));
        ob[i] = pk2(x2l * RC_(2 * i) + x1l * RS_(2 * i), x2h * RC_(2 * i + 1) + x1h * RS_(2 * i + 1));
    }
    a = oa; b = ob;
#undef RC_
#undef RS_
}
__device__ __forceinline__ void rope16(u32x4& a, u32x4& b, const float* ct, const float* st) {
    rope16v(a, b, *(const f32x4*)ct, *(const f32x4*)(ct + 4), *(const f32x4*)st, *(const f32x4*)(st + 4));
}

__device__ __forceinline__ float xhalf_max(float v) { auto rr = __builtin_amdgcn_permlane32_swap(__float_as_uint(v), __float_as_uint(v), false, false); return fmaxf(__uint_as_float(rr[0]), __uint_as_float(rr[1])); }
__device__ __forceinline__ float xhalf_sum(float v) { auto rr = __builtin_amdgcn_permlane32_swap(__float_as_uint(v), __float_as_uint(v), false, false); return __uint_as_float(rr[0]) + __uint_as_float(rr[1]); }
template <int QB, bool ROPE, bool BIAS>
__device__ __forceinline__ void attn_super(const AttnHalf& U, int ntiles, LAS unsigned char* ldsbase, const float* ropetab, int tid) {
    const int lane = tid & 63, r32 = lane & 31, hi = lane >> 5, tidh = tid & 255, waveh = (tid >> 6) & 3, half = tid >> 8;
    LAS unsigned char* lds = ldsbase + half * AT_HALF;
    const int qlo = U.q0 + waveh * 32 * QB, qhi = qlo + 32 * QB - 1;
    bf16x8 qf[QB][4]; float cqv[QB];
#pragma unroll
    for (int qb = 0; qb < QB; ++qb) {
        const int qi = qlo + 32 * qb + r32; const bf16* src = U.Q + (size_t)qi * U.q_stride;
#pragma unroll
        for (int d0 = 0; d0 < 4; ++d0) qf[qb][d0] = *(const bf16x8*)(src + 16 * d0 + 8 * hi);
        if (ROPE) { u32x4 a = *(const u32x4*)src, b = *(const u32x4*)(src + 8); const int pos = U.pos0 + qi * U.pos_step;
            rope16(a, b, ropetab + pos * 8, ropetab + SEQ * 8 + pos * 8); qf[qb][0] = __builtin_bit_cast(bf16x8, hi ? b : a); }
        cqv[qb] = BIAS ? U.cq[qi] : 0.f;
    }
    f32x16 OT[QB][2]; float mrun[QB], lrun[QB];
#pragma unroll
    for (int qb = 0; qb < QB; ++qb) { mrun[qb] = -1e30f; lrun[qb] = 0.f;
#pragma unroll
        for (int dh = 0; dh < 2; ++dh)
#pragma unroll
            for (int r = 0; r < 16; ++r) OT[qb][dh][r] = 0.f; }
    u32x4 kr0, kr1, vr0, vr1; f32x4 ckr = (f32x4){0.f, 0.f, 0.f, 0.f};
    f32x4 rc0 = ckr, rc1 = ckr, rs0 = ckr, rs1 = ckr;
    const int trow = tidh >> 2, tseg = tidh & 3;
#define AT_LOAD(t) do { const int kv0_ = U.kv_begin + 64 * (t); const int kvc_ = kv0_ < 0 ? 0 : kv0_; \
        const bf16* ks_ = U.K + (size_t)(kvc_ + trow) * U.k_stride + 16 * tseg; kr0 = *(const u32x4*)ks_; kr1 = *(const u32x4*)(ks_ + 8); \
        const bf16* vs_ = U.VT + (size_t)trow * U.vt_pitch + kvc_ + 16 * tseg; vr0 = *(const u32x4*)vs_; vr1 = *(const u32x4*)(vs_ + 8); \
        if (BIAS) { if (tidh < 16) ckr = *(const f32x4*)(U.cq + kvc_ + 4 * tidh); } \
        if (ROPE) { if (tseg == 0) { const int pos_ = U.pos0 + (kvc_ + trow) * U.pos_step; const float* ct_ = ropetab + pos_ * 8; \
            rc0 = *(const f32x4*)ct_; rc1 = *(const f32x4*)(ct_ + 4); rs0 = *(const f32x4*)(ct_ + SEQ * 8); rs1 = *(const f32x4*)(ct_ + SEQ * 8 + 4); } } } while (0)
#define AT_STORE(buf) do { LAS unsigned char* b_ = lds + (buf) * AT_BUF; \
        if (ROPE) { if (tseg == 0) rope16v(kr0, kr1, rc0, rc1, rs0, rs1); } \
        *(LAS u32x4*)(b_ + AT_K + trow * AT_PITCH + tseg * 32) = kr0; *(LAS u32x4*)(b_ + AT_K + trow * AT_PITCH + tseg * 32 + 16) = kr1; \
        *(LAS u32x4*)(b_ + AT_V + trow * AT_PITCH + tseg * 32) = vr0; *(LAS u32x4*)(b_ + AT_V + trow * AT_PITCH + tseg * 32 + 16) = vr1; \
        if (BIAS) { if (tidh < 16) *(LAS f32x4*)(b_ + AT_CK + 16 * tidh) = ckr; } } while (0)
    AT_LOAD(0); AT_STORE(0);
    __syncthreads();
    for (int t = 0; t < ntiles; ++t) {
        if (t + 1 < ntiles) AT_LOAD(t + 1);
        const LAS unsigned char* bb = lds + (t & 1) * AT_BUF;
        const int kv0 = U.kv_begin + 64 * t;
#pragma unroll 1
        for (int kb = 0; kb < 2; ++kb) {
            const int kvb = kv0 + 32 * kb;
            if (kvb < 0 || kvb > qhi || qlo - (kvb + 31) > U.nback) continue;
            bf16x8 kf[4];
#pragma unroll
            for (int d0 = 0; d0 < 4; ++d0) kf[d0] = *(const LAS bf16x8*)(bb + AT_K + (32 * kb + r32) * AT_PITCH + (16 * d0 + 8 * hi) * 2);
            bf16x8 pa[QB][2];
#pragma unroll
            for (int qb = 0; qb < QB; ++qb) {
                f32x4 ck4[4];
                if (BIAS) {
#pragma unroll
                    for (int jj = 0; jj < 4; ++jj) ck4[jj] = *(const LAS f32x4*)(bb + AT_CK + (32 * kb + 8 * jj + 4 * hi) * 4);
                    if (QB > 1) asm volatile("" ::: "memory");
                }
                f32x16 S;
#pragma unroll
                for (int r = 0; r < 16; ++r) S[r] = BIAS ? (cqv[qb] - ck4[r >> 2][r & 3]) : 0.f;
#pragma unroll
                for (int d0 = 0; d0 < 4; ++d0) S = __builtin_amdgcn_mfma_f32_32x32x16_bf16(kf[d0], qf[qb][d0], S, 0, 0, 0);
                const int qb0 = qlo + 32 * qb, qi = qb0 + r32;
                if (kvb + 31 > qb0 || qb0 + 31 - kvb > U.nback) {
#pragma unroll
                    for (int r = 0; r < 16; ++r) { const int kvj = kvb + crow(r, hi); const bool ok = (kvj <= qi) && (qi - kvj <= U.nback); S[r] = ok ? S[r] : -INFINITY; }
                }
                float mx = S[0];
#pragma unroll
                for (int r = 1; r < 16; ++r) mx = fmaxf(mx, S[r]);
                mx = xhalf_max(mx);
                const float mnew = fmaxf(mrun[qb], mx);
                const float alpha = __builtin_amdgcn_exp2f(mrun[qb] - mnew);
                if (__any(mnew > mrun[qb])) {
#pragma unroll
                    for (int dh = 0; dh < 2; ++dh)
#pragma unroll
                        for (int r = 0; r < 16; ++r) OT[qb][dh][r] *= alpha;
                }
                mrun[qb] = mnew;
                float ps = 0.f;
#pragma unroll
                for (int r = 0; r < 16; ++r) { S[r] = __builtin_amdgcn_exp2f(S[r] - mnew); ps += S[r]; }
                lrun[qb] = lrun[qb] * alpha + ps;
#pragma unroll
                for (int ks = 0; ks < 2; ++ks) { u32x4 w; w.x = pk2(S[8 * ks], S[8 * ks + 1]); w.y = pk2(S[8 * ks + 2], S[8 * ks + 3]); w.z = pk2(S[8 * ks + 4], S[8 * ks + 5]); w.w = pk2(S[8 * ks + 6], S[8 * ks + 7]);
                    pa[qb][ks] = __builtin_bit_cast(bf16x8, w); }
            }
#pragma unroll
            for (int ks = 0; ks < 2; ++ks)
#pragma unroll
                for (int dh = 0; dh < 2; ++dh) {
                    const LAS unsigned char* vp = bb + AT_V + (32 * dh + r32) * AT_PITCH + (32 * kb + 16 * ks + 4 * hi) * 2;
                    const s16x4 lo = *(const LAS s16x4*)vp, hi4 = *(const LAS s16x4*)(vp + 16);
                    const bf16x8 vf = (bf16x8){lo[0], lo[1], lo[2], lo[3], hi4[0], hi4[1], hi4[2], hi4[3]};
#pragma unroll
                    for (int qb = 0; qb < QB; ++qb) OT[qb][dh] = __builtin_amdgcn_mfma_f32_32x32x16_bf16(vf, pa[qb][ks], OT[qb][dh], 0, 0, 0);
                }
        }
        if (t + 1 < ntiles) AT_STORE((t + 1) & 1);
        __syncthreads();
    }
#undef AT_LOAD
#undef AT_STORE
#pragma unroll
    for (int qb = 0; qb < QB; ++qb) {
        const float l = xhalf_sum(lrun[qb]); const float inv = 1.0f / l;
        const int qi = qlo + 32 * qb + r32; bf16* op = U.O + (size_t)qi * U.o_stride;
#pragma unroll
        for (int dh = 0; dh < 2; ++dh)
#pragma unroll
            for (int r4 = 0; r4 < 4; ++r4) { u32x2 w; w.x = pk2(OT[qb][dh][4 * r4] * inv, OT[qb][dh][4 * r4 + 1] * inv); w.y = pk2(OT[qb][dh][4 * r4 + 2] * inv, OT[qb][dh][4 * r4 + 3] * inv);
                *(u32x2*)(op + 32 * dh + 8 * r4 + 4 * hi) = w; }
        if (U.lse && hi == 0) U.lse[(size_t)qi * U.lse_stride] = mrun[qb] + __builtin_amdgcn_logf(l);
    }
}

#define XB_TMO      128
#define XB_XCNT(j)  (256  + 64 * (j))
#define XB_XSUB(j)  (1280 + 64 * (j))
#define XB_XGEN(j)  (2304 + 64 * (j))
#define XB_TOP      3328
#define XB_TOPGEN   3392
#define XCD_BAR_WORDS 3456
#define XB_SPIN_CAP (1u << 18)

__device__ __forceinline__ unsigned xb_ld(unsigned* p)              { return __hip_atomic_load(p, __ATOMIC_RELAXED, __HIP_MEMORY_SCOPE_AGENT); }
__device__ __forceinline__ unsigned xb_add(unsigned* p, unsigned v) { return __hip_atomic_fetch_add(p, v, __ATOMIC_RELAXED, __HIP_MEMORY_SCOPE_AGENT); }
__device__ __forceinline__ unsigned xb_xcc_id() { return (unsigned)__builtin_amdgcn_s_getreg((3 << 11) | 20) & 0xFu; }
#define XB_SPIN(cond, bar) do { unsigned _sp = 0; while (cond) { __builtin_amdgcn_s_sleep(1); \
    if ((++_sp & 255u) == 0u) { if (xb_ld(&(bar)[XB_TMO])) break; if (_sp > XB_SPIN_CAP) { atomicAdd(&(bar)[XB_TMO], 1u); break; } } } } while (0)

struct XcdBarrier {
    unsigned* bar; unsigned x;
    volatile LAS unsigned* st;
};

__device__ __forceinline__ XcdBarrier xcd_barrier_post(unsigned* bar, volatile LAS unsigned* st) {
    XcdBarrier b; b.bar = bar; b.x = xb_xcc_id(); b.st = st;
    if (threadIdx.x == 0) (void)xb_add(&bar[XB_XCNT(b.x)], 1u);
    return b;
}
__device__ __forceinline__ void xcd_barrier_complete(unsigned* bar, unsigned x, unsigned& nloc, unsigned& nx) {
    const unsigned G = gridDim.x * gridDim.y * gridDim.z;
    unsigned sum, cnt, mine, sp = 0u;
    for (;;) {
        sum = 0u; cnt = 0u; mine = 0u;
#pragma unroll
        for (unsigned j = 0; j < 16; ++j) { const unsigned c = xb_ld(&bar[XB_XCNT(j)]); sum += c; cnt += (c > 0u) ? 1u : 0u; mine = (j == x) ? c : mine; }
        if (sum == G) break;
        __builtin_amdgcn_s_sleep(1);
        if ((++sp & 255u) == 0u) { if (xb_ld(&bar[XB_TMO])) break; if (sp > XB_SPIN_CAP) { atomicAdd(&bar[XB_TMO], 1u); break; } }
    }
    nloc = mine > 0u ? mine : 1u; nx = cnt > 0u ? cnt : 1u;
}

__device__ __forceinline__ void xcd_barrier(const XcdBarrier& b) {
    asm volatile("s_waitcnt vmcnt(0)" ::: "memory");
    __syncthreads();
    if (threadIdx.x == 0) {
        unsigned* bar = b.bar;
        __builtin_amdgcn_s_waitcnt(0);
        unsigned nloc = b.st[0], nx = b.st[1];
        if (nloc == 0u) { xcd_barrier_complete(bar, b.x, nloc, nx); b.st[0] = nloc; b.st[1] = nx; }
        const unsigned old = xb_add(&bar[XB_XSUB(b.x)], 1u);
        const unsigned gen = old / nloc;
        if (old + 1u == (gen + 1u) * nloc) {
            __builtin_amdgcn_fence(__ATOMIC_RELEASE, "agent");
            asm volatile("s_waitcnt vmcnt(0)" ::: "memory");
            const unsigned og = xb_add(&bar[XB_TOP], 1u);
            const unsigned tg = og / nx;
            if (og + 1u == (tg + 1u) * nx) xb_add(&bar[XB_TOPGEN], 1u);
            else XB_SPIN(xb_ld(&bar[XB_TOPGEN]) == tg, bar);
            __builtin_amdgcn_fence(__ATOMIC_ACQUIRE, "agent");
            xb_add(&bar[XB_XGEN(b.x)], 1u);
            asm volatile("s_waitcnt vmcnt(0)" ::: "memory");
        } else {
            XB_SPIN(xb_ld(&bar[XB_XGEN(b.x)]) == gen, bar);
            __builtin_amdgcn_fence(__ATOMIC_ACQUIRE, "agent");
            asm volatile("s_waitcnt vmcnt(0)" ::: "memory");
        }
    }
    __syncthreads();
}

struct Args { const float* in[13]; float* out; unsigned char* ws; float invf[8]; int ph_lo, ph_hi; };
enum { IN_X = 0, IN_GAINS, IN_WQKV_A, IN_WO_A, IN_WQ_B, IN_WO_B, IN_KVNORM, IN_WKVF, IN_BF, IN_WUP, IN_CONVW, IN_CONVB, IN_WDOWN };

__host__ __device__ inline bool phase_noop(int ph) { if (ph == 0) return false; const int l = (ph - 1) / 9, s = (ph - 1) % 9; return (s == 2 && l >= 2); }

#define PH_LOCALS() \
    int tid = threadIdx.x; asm volatile("" : "+v"(tid)); \
    const int lane = tid & 63, wave = __builtin_amdgcn_readfirstlane(tid >> 6); \
    const int G = gridDim.x, bx = blockIdx.x, gw = bx * 8 + wave, NGW = G * 8; \
    unsigned char* ws = a.ws; float* h = a.out; \
    bf16* xn = (bf16*)(ws + WS_XN); float* Fb = (float*)(ws + WS_F); \
    const float* gains = a.in[IN_GAINS]; const float* ropetab = (const float*)(ws + WS_ROPE); \
    (void)lane; (void)wave; (void)gw; (void)NGW; (void)h; (void)xn; (void)Fb; (void)gains; (void)ropetab; (void)G; (void)bx
#ifndef PROBE_REP
#define PROBE_REP 0
#endif
#ifndef PROBE_SYNC2
#define PROBE_SYNC2 0
#endif
#ifndef PROBE_LAYERS
#define PROBE_LAYERS 0xF
#endif
__host__ __device__ constexpr int phase_reps_raw(int k) { return (k == 0) ? (((PROBE_REP >> 9) & 1) ? 2 : 1) : ((((PROBE_REP >> ((k - 1) % 9)) & 1) && ((PROBE_LAYERS >> ((k - 1) / 9)) & 1)) ? 2 : 1); }
__host__ __device__ constexpr bool phase_is_gemm(int k) { return k > 0 && (((k - 1) % 9) == 0 || ((k - 1) % 9) == 3 || ((k - 1) % 9) == 5 || ((k - 1) % 9) == 7); }
__host__ __device__ constexpr int phase_reps(int k) { return phase_is_gemm(k) ? 1 : phase_reps_raw(k); }
#define PH_BEGIN(k) if (a.ph_lo <= (k) && (k) < a.ph_hi) { for (int rep_ = 0; rep_ < phase_reps(k); ++rep_) { if (rep_) grid.sync(); PH_LOCALS();
#define SEAM1(k) do { if ((k) == 0) { grid.sync(); (void)xcd_barrier_post((unsigned*)(a.ws + WS_BAR), (volatile LAS unsigned*)(lds + LDS_MISC)); } \
    else { XcdBarrier b_; b_.bar = (unsigned*)(a.ws + WS_BAR); b_.x = xb_xcc_id(); b_.st = (volatile LAS unsigned*)(lds + LDS_MISC); xcd_barrier(b_); } } while (0)
#define PH_END(k) } if ((k) + 1 < a.ph_hi) { SEAM1(k); if (PROBE_SYNC2 && (k) != 0) SEAM1(k); } }

template <int L>
__device__ __forceinline__ void run_layer(const Args& a, LAS unsigned char* lds, cg::grid_group& grid) {
    constexpr int base = 1 + 9 * L; constexpr bool isA = L < 2; constexpr int l = L;
    PH_BEGIN(base + 0)
        if (L == 2) { if (gw < BATCH * 16) scan_unit((const float*)(ws + WS_FLOG), (float*)(ws + WS_C2), gw, lane); }
        constexpr int njobs = isA ? 4 : (L == 2 ? 2 : 1);
        for (int j = 0; j < njobs; ++j) {
            pg8::Gemm g; bf16* O; int ldc, split = 0, rot = 0; size_t sstride = 0;
            if (isA) {
                if (j == 0) { g = pg8::Gemm{xn, (const bf16*)(ws + W_QK_A + l * 3 * MiB), MROWS, 1536, DM}; O = (bf16*)(ws + G_QK_A); ldc = 1536; }
                else { const bf16* Bt = (j == 1) ? xn : (j == 2) ? (const bf16*)(ws + G_XP1) : (const bf16*)(ws + G_XP2);
                    g = pg8::Gemm{(const bf16*)(ws + W_V_A + l * 3 * MiB / 2) + (size_t)(j - 1) * 256 * DM, Bt, 256, MROWS, DM};
                    O = (bf16*)(ws + G_VT_A) + (size_t)(j - 1) * 256 * MROWS; ldc = MROWS; rot = (j == 1) ? 128 : (j == 2) ? 64 : 0; }
            } else if (L == 2) {
                if (j == 0) { g = pg8::Gemm{xn, (const bf16*)(ws + W_QK_B), MROWS, 2048, DM}; O = (bf16*)(ws + G_Q_B); ldc = DM; split = DM; sstride = (G_K_B - G_Q_B) / 2; }
                else { g = pg8::Gemm{(const bf16*)(ws + W_V_B), xn, DM, MROWS, DM}; O = (bf16*)(ws + G_VT_B); ldc = MROWS; }
            } else { g = pg8::Gemm{xn, (const bf16*)(ws + W_Q_B1), MROWS, DM, DM}; O = (bf16*)(ws + G_Q_B); ldc = DM; }
            pg8::StaticOrder S; S.init(g.M, g.N, G, (bx + rot) % G); S.reps = phase_reps_raw(base + 0);
            pg8::EpiBf16<0> E{O, ldc, nullptr, split, sstride, 1.f};
            pg8::gemm_phase<pg8::EpiBf16<0>, pg8::StaticOrder, true, true>(lds, g, S, E);
            __syncthreads();
        }
    PH_END(base + 0)
    PH_BEGIN(base + 1)
        if (isA) {
            for (int su = bx; su < 768; su += G) {
                const int grp = su >> 8, hu = 2 * (su & 255) + (tid >> 8);
                const int r = (grp == 0) ? 1 : (grp == 1) ? 4 : 16, Lq = SEQ / r, nqb = Lq / 128;
                const int j = hu & 3, qb = (hu >> 2) % nqb, sq = (hu >> 2) / nqb, b = sq / r, rho = sq % r, hd12 = grp * 4 + j;
                AttnHalf U;
                const size_t row0 = (size_t)b * SEQ + rho;
                U.Q = (const bf16*)(ws + G_QK_A) + row0 * 1536 + hd12 * 64; U.K = U.Q + 768; U.q_stride = r * 1536; U.k_stride = r * 1536;
                U.VT = (const bf16*)(ws + G_VT_A) + (size_t)(grp * 256 + j * 64) * MROWS + (size_t)b * SEQ + (size_t)rho * Lq; U.vt_pitch = MROWS;
                U.O = (bf16*)(ws + G_O_A) + row0 * AW + hd12 * 64; U.o_stride = r * AW;
                U.lse = (float*)(ws + WS_LSE) + row0 * 12 + hd12; U.lse_stride = r * 12; U.cq = nullptr;
                U.q0 = qb * 128; U.kv_begin = U.q0 - 128; U.nback = 128; U.pos0 = rho; U.pos_step = r;
                attn_super<1, true, false>(U, 4, lds, ropetab, tid);
            }
        } else {
            for (int i = 0; i < 2; ++i) {
                for (int w = bx; w < 256; w += G) {
                    const int pair = w >> 2, sx = w & 3, qb = (i == 0) ? sx : 7 - sx;
                    const int b = pair >> 3, hd = 2 * (pair & 7) + (tid >> 8);
                    AttnHalf U;
                    U.Q = (const bf16*)(ws + G_Q_B) + (size_t)b * SEQ * DM + hd * 64; U.K = (const bf16*)(ws + G_K_B) + (size_t)b * SEQ * DM + hd * 64; U.q_stride = DM; U.k_stride = DM;
                    U.VT = (const bf16*)(ws + G_VT_B) + (size_t)(hd * 64) * MROWS + (size_t)b * SEQ; U.vt_pitch = MROWS;
                    U.O = (bf16*)(ws + G_O_B) + (size_t)b * SEQ * DM + hd * 64; U.o_stride = DM; U.lse = nullptr; U.lse_stride = 0;
                    U.cq = (const float*)(ws + WS_C2) + (size_t)(b * 16 + hd) * SEQ;
                    U.q0 = qb * 256; U.kv_begin = 0; U.nback = 1 << 30; U.pos0 = 0; U.pos_step = 0;
                    attn_super<2, false, true>(U, 4 * (qb + 1), lds, ropetab, tid);
                }
            }
        }
    PH_END(base + 1)
    if (isA) {
    PH_BEGIN(base + 2)
        const float* lse = (const float*)(ws + WS_LSE); bf16* o = (bf16*)(ws + G_O_A);
        for (int idx = bx * 512 + tid; idx < MROWS * 96; idx += G * 512) {
            const int m = idx / 96, hd12 = (idx >> 3) % 12, j = hd12 & 3, grp = hd12 >> 2;
            const float l0 = lse[(size_t)m * 12 + j], l1 = lse[(size_t)m * 12 + 4 + j], l2 = lse[(size_t)m * 12 + 8 + j];
            const float mx = fmaxf(l0, fmaxf(l1, l2));
            const float e0 = __builtin_amdgcn_exp2f(l0 - mx), e1 = __builtin_amdgcn_exp2f(l1 - mx), e2 = __builtin_amdgcn_exp2f(l2 - mx);
            const float wgt = ((grp == 0) ? e0 : (grp == 1) ? e1 : e2) / (e0 + e1 + e2);
            u32x4 v = *(const u32x4*)(o + (size_t)idx * 8);
#pragma unroll
            for (int e = 0; e < 4; ++e) v[e] = pk2(bf_lo(v[e]) * wgt, bf_hi(v[e]) * wgt);
            *(u32x4*)(o + (size_t)idx * 8) = v;
        }
    PH_END(base + 2)
    }
    PH_BEGIN(base + 3)
        pg8::Gemm g;
        if (isA) g = pg8::Gemm{(const bf16*)(ws + G_O_A), (const bf16*)(ws + W_O_A + l * 3 * MiB / 2), MROWS, DM, AW};
        else g = pg8::Gemm{(const bf16*)(ws + G_O_B), (const bf16*)(ws + W_O_B + (l - 2) * 2 * MiB), MROWS, DM, DM};
        pg8::StaticOrder S; S.init(g.M, g.N, G, bx); S.reps = phase_reps_raw(base + 3);
        pg8::EpiBf16<0> E{(bf16*)Fb, DM, nullptr, 0, 0, 1.f};
        pg8::gemm_phase<pg8::EpiBf16<0>, pg8::StaticOrder, true, true>(lds, g, S, E);
    PH_END(base + 3)
    PH_BEGIN(base + 4)
        row_phase<1>(Fb, gains + (l * 4 + 1) * DM, h, xn, nullptr, nullptr, true, false, false, (const LAS float*)lds, nullptr, nullptr, gw, NGW, lane);
    PH_END(base + 4)
    PH_BEGIN(base + 5)
        pg8::Gemm g{xn, (const bf16*)(ws + W_UP + l * 11 * MiB), MROWS, NUP, DM};
        pg8::StaticOrder S; S.init(g.M, g.N, G, bx); S.reps = phase_reps_raw(base + 5);
        pg8::EpiConvGlu E{(bf16*)(ws + G_U), Fb, a.in[IN_CONVW] + (size_t)l * 3 * NUP, a.in[IN_CONVB] + (size_t)l * NUP};
        pg8::gemm_phase<pg8::EpiConvGlu, pg8::StaticOrder, true, true>(lds, g, S, E);
    PH_END(base + 5)
    PH_BEGIN(base + 6)
        const float* side = Fb; const float* cw = a.in[IN_CONVW] + (size_t)l * 3 * NUP; const float* cb = a.in[IN_CONVB] + (size_t)l * NUP; bf16* Ub = (bf16*)(ws + G_U);
        for (int idx = bx * 512 + tid; idx < 256 * 2 * 704; idx += G * 512) {
            const int cg4 = idx % 704, rr = (idx / 704) & 1, c = idx / 1408, ch = 4 * cg4; const bool first = (c % 32) == 0;
            f32x4 o;
#pragma unroll
            for (int hv = 0; hv < 2; ++hv) {
                const int col = hv * DFF + ch; const f32x4 z = (f32x4){0.f, 0.f, 0.f, 0.f};
                const f32x4 s0 = *(const f32x4*)(side + (size_t)(c * 4 + 0) * NUP + col);
                const f32x4 p3 = first ? z : *(const f32x4*)(side + (size_t)(c * 4 - 1) * NUP + col);
                f32x4 at, at1, at2;
                if (rr == 0) { at = s0; at1 = p3; at2 = first ? z : *(const f32x4*)(side + (size_t)(c * 4 - 2) * NUP + col); }
                else { at = *(const f32x4*)(side + (size_t)(c * 4 + 1) * NUP + col); at1 = s0; at2 = p3; }
                const f32x4 r = *(const f32x4*)(cw + col) * at2 + *(const f32x4*)(cw + NUP + col) * at1 + *(const f32x4*)(cw + 2 * NUP + col) * at + *(const f32x4*)(cb + col);
                if (hv == 0) { o.x = pg8::gelu_tanh(r.x); o.y = pg8::gelu_tanh(r.y); o.z = pg8::gelu_tanh(r.z); o.w = pg8::gelu_tanh(r.w); } else o = o * r;
            }
            u32x2 w; w.x = pk2(o.x, o.y); w.y = pk2(o.z, o.w);
            *(u32x2*)(Ub + (size_t)(c * 64 + rr) * DFF + ch) = w;
        }
    PH_END(base + 6)
    PH_BEGIN(base + 7)
        pg8::Gemm g{(const bf16*)(ws + G_U), (const bf16*)(ws + W_DN + l * 11 * MiB / 2), MROWS, DM, DFF};
        pg8::StaticOrder S; S.init(g.M, g.N, G, bx); S.reps = phase_reps_raw(base + 7);
        pg8::EpiBf16<0> E{(bf16*)Fb, DM, nullptr, 0, 0, 1.f};
        pg8::gemm_phase<pg8::EpiBf16<0>, pg8::StaticOrder, true, true>(lds, g, S, E);
    PH_END(base + 7)
    PH_BEGIN(base + 8)
        constexpr bool last = (L == NLAYER - 1), forget = (L == 1);
        if (forget) { const float* wsrc = (const float*)(ws + WS_WFT); LAS float* wl = (LAS float*)lds;
            for (int i = tid; i < 16 * DM / 4; i += 512) *(LAS f32x4*)(wl + 4 * i) = *(const f32x4*)(wsrc + 4 * i);
            __syncthreads(); }
        row_phase<1>(Fb, gains + (l * 4 + 3) * DM, h, xn, (bf16*)(ws + G_XP1), (bf16*)(ws + G_XP2), !last, L == 0, forget, (const LAS float*)lds, a.in[IN_BF], (float*)(ws + WS_FLOG), gw, NGW, lane);
    PH_END(base + 8)
}

__global__ void __launch_bounds__(512, 2) yoco_fwd(Args a) {
    extern __shared__ __attribute__((aligned(16))) unsigned char lds_raw[];
    LAS unsigned char* lds = (LAS unsigned char*)lds_raw;
    cg::grid_group grid = cg::this_grid();
    if (threadIdx.x < 2) ((volatile LAS unsigned*)(lds + LDS_MISC))[threadIdx.x] = 0u;
    __syncthreads();
    PH_BEGIN(0)
        if (bx == 0) { unsigned* bw = (unsigned*)(ws + WS_BAR); for (int i = tid; i < XCD_BAR_WORDS; i += 512) bw[i] = 0u; }
        LAS float* scr = (LAS float*)(lds + wave * 16384);
        int off = 0;
        for (int l = 0; l < 2; ++l) {
            const float* g0 = gains + (l * 4 + 0) * DM; const float* W = a.in[IN_WQKV_A] + (size_t)l * DM * 2304;
            conv_mat(W, 2304, DM, 0, 768, (bf16*)(ws + W_QK_A + l * 3 * MiB), 0, g0, QSCALE, scr, gw, NGW, lane, off);
            conv_mat(W, 2304, DM, 768, 768, (bf16*)(ws + W_QK_A + l * 3 * MiB) + (size_t)768 * DM, 0, g0, 1.f, scr, gw, NGW, lane, off);
            conv_mat(W, 2304, DM, 1536, 768, (bf16*)(ws + W_V_A + l * 3 * MiB / 2), 0, g0, 1.f, scr, gw, NGW, lane, off);
            conv_mat(a.in[IN_WO_A] + (size_t)l * AW * DM, DM, AW, 0, DM, (bf16*)(ws + W_O_A + l * 3 * MiB / 2), 0, nullptr, 1.f, scr, gw, NGW, lane, off);
        }
        {
            const float* kvn = a.in[IN_KVNORM];
            conv_mat(a.in[IN_WQ_B], DM, DM, 0, DM, (bf16*)(ws + W_QK_B), 0, gains + (2 * 4 + 0) * DM, QSCALE, scr, gw, NGW, lane, off);
            conv_mat(a.in[IN_WKVF], 2064, DM, 0, DM, (bf16*)(ws + W_QK_B) + (size_t)DM * DM, 0, kvn, 1.f, scr, gw, NGW, lane, off);
            conv_mat(a.in[IN_WKVF], 2064, DM, DM, DM, (bf16*)(ws + W_V_B), 0, kvn, 1.f, scr, gw, NGW, lane, off);
            conv_mat(a.in[IN_WQ_B] + (size_t)DM * DM, DM, DM, 0, DM, (bf16*)(ws + W_Q_B1), 0, gains + (3 * 4 + 0) * DM, QSCALE, scr, gw, NGW, lane, off);
            for (int j = 0; j < 2; ++j) conv_mat(a.in[IN_WO_B] + (size_t)j * DM * DM, DM, DM, 0, DM, (bf16*)(ws + W_O_B + j * 2 * MiB), 0, nullptr, 1.f, scr, gw, NGW, lane, off);
        }
        for (int l = 0; l < NLAYER; ++l) {
            conv_mat(a.in[IN_WUP] + (size_t)l * DM * NUP, NUP, DM, 0, NUP, (bf16*)(ws + W_UP + l * 11 * MiB), 1, gains + (l * 4 + 2) * DM, 1.f, scr, gw, NGW, lane, off);
            conv_mat(a.in[IN_WDOWN] + (size_t)l * DFF * DM, DM, DFF, 0, DM, (bf16*)(ws + W_DN + l * 11 * MiB / 2), 0, nullptr, 1.f, scr, gw, NGW, lane, off);
        }
        const int gt = bx * 512 + tid;
        if (gt < SEQ * 8) { const int pos = gt >> 3, i = gt & 7; float sn, cs; sincos_f64((float)pos * a.invf[i], sn, cs);
            ((float*)(ws + WS_ROPE))[gt] = cs; ((float*)(ws + WS_ROPE))[SEQ * 8 + gt] = sn; }
        if (gt < 16 * DM) { const int hd = gt >> 10, k = gt & 1023; ((float*)(ws + WS_WFT))[gt] = a.in[IN_WKVF][(size_t)k * 2064 + 2048 + hd] * a.in[IN_KVNORM][k]; }
        row_phase<0>(a.in[IN_X], nullptr, h, xn, (bf16*)(ws + G_XP1), (bf16*)(ws + G_XP2), true, true, false, (const LAS float*)lds, nullptr, nullptr, gw, NGW, lane);
    PH_END(0)
    run_layer<0>(a, lds, grid);
    run_layer<1>(a, lds, grid);
    run_layer<2>(a, lds, grid);
    run_layer<3>(a, lds, grid);
}

#ifndef MK_SINGLE
#define MK_SINGLE 1
#endif
extern "C" void kernel_launch(void* const* d_in, const int* in_sizes, int n_in, void* d_out, int out_size, void* d_ws, size_t ws_size, hipStream_t stream) {
    static int grid = 0;
    if (grid == 0) {
        if (n_in != 13 || out_size != MROWS * DM || ws_size < WS_END) { fprintf(stderr, "kernel_launch: unexpected shapes (n_in %d, out %d, ws %zu)\n", n_in, out_size, ws_size); grid = -1; return; }
        int dev = 0, cus = 0, per_cu = 0;
        hipGetDevice(&dev); hipDeviceGetAttribute(&cus, hipDeviceAttributeMultiprocessorCount, dev);
        if (hipFuncSetAttribute((const void*)yoco_fwd, hipFuncAttributeMaxDynamicSharedMemorySize, LDS_BYTES) != hipSuccess) { fprintf(stderr, "kernel_launch: hipFuncSetAttribute failed\n"); grid = -1; return; }
        hipOccupancyMaxActiveBlocksPerMultiprocessor(&per_cu, (const void*)yoco_fwd, 512, LDS_BYTES);
        if (per_cu < 1) { fprintf(stderr, "kernel_launch: occupancy query says %d\n", per_cu); per_cu = 1; }
        (void)hipGetLastError();
        grid = cus * 1;
        fprintf(stderr, "kernel_launch: grid %d (per_cu %d)\n", grid, per_cu);
    }
    if (grid < 0) return;
    Args a{};
    for (int i = 0; i < 13; ++i) a.in[i] = (const float*)d_in[i];
    a.out = (float*)d_out; a.ws = (unsigned char*)d_ws;
    for (int i = 0; i < 8; ++i) a.invf[i] = powf(500000.0f, -(float)(2 * i) / 16.0f);
#if MK_SINGLE
    a.ph_lo = 0; a.ph_hi = NPHASE;
    void* args[] = {&a};
    hipError_t e = hipLaunchCooperativeKernel((const void*)yoco_fwd, dim3(grid), dim3(512), args, LDS_BYTES, stream);
    if (e != hipSuccess) fprintf(stderr, "cooperative launch failed: %s (grid %d)\n", hipGetErrorString(e), grid);
#else
    for (int ph = 0; ph < NPHASE; ++ph) {
        if (phase_noop(ph)) continue;
        a.ph_lo = ph; a.ph_hi = ph + 1;
        hipLaunchKernelGGL(yoco_fwd, dim3(grid), dim3(512), LDS_BYTES, stream, a);
    }
#endif
}
```

```cpp
#include <hip/hip_runtime.h>
#include <hip/hip_cooperative_groups.h>
#include <cstdio>
#include <cstdint>
#include <cmath>
namespace cg = cooperative_groups;
namespace pg8 {
#define PG8_LAS __attribute__((address_space(3)))
typedef unsigned short bf16_t;
typedef short bf16x8 __attribute__((ext_vector_type(8)));
typedef float f32x4 __attribute__((ext_vector_type(4)));
typedef unsigned u32x4 __attribute__((ext_vector_type(4)));
constexpr int BM = 256, BK = 64, HALF = 128, HTB = HALF * BK * 2  , STAGE_BYTES = 8 * HTB, NXCD = 8, WGM = 8;

__host__ __device__ __forceinline__ int lds_byte(int r, int c) { const int st = (r >> 4) * 2 + (c >> 5), rr = r & 15, cc = c & 31, ob = rr * 64 + cc * 2; return st * 1024 + (ob ^ (((ob >> 9) & 1) << 5)); }
__host__ __device__ __forceinline__ void stage_rc(int b, int& R, int& C) { const int st = b / 1024, sb = b % 1024, swz = sb ^ (((sb >> 9) & 1) << 5); R = (st >> 1) * 16 + swz / 64; C = (st & 1) * 32 + (swz % 64) / 2; }
__host__ __device__ __forceinline__ int perm32(int rho) { const int n = rho >> 4, i = rho & 15; return 8 * (i >> 2) + 4 * n + (i & 3); }

struct Unit { int pm, pn; };
struct Gemm { const bf16_t* A; const bf16_t* Bt; int M, N, K; };

struct StaticOrder {
    int nM, nN, nwg, G, c, reps;
    __host__ __device__ void init(int M, int N, int G_, int c_) { nM = M / BM; nN = N / BM; nwg = nM * nN; G = G_; c = c_; reps = 1; }
    __host__ __device__ bool next(int i, Unit& u) const {
        if (reps > 1) { const int nmine = (c < nwg) ? (nwg - c + G - 1) / G : 0; if (i >= reps * nmine) return false; i = i % nmine; }
        const long L = (long)i * G + c; if (L >= nwg) return false;
        int wgid = (int)L; { const int q = nwg / NXCD, r = nwg % NXCD, xcd = wgid % NXCD, off = wgid / NXCD; wgid = (xcd < r ? xcd * (q + 1) : r * (q + 1) + (xcd - r) * q) + off; }
        const int nig = WGM * nN, gid = wgid / nig, fm = gid * WGM, gsz = (nM - fm) < WGM ? (nM - fm) : WGM;
        u.pm = fm + ((wgid % nig) % gsz); u.pn = (wgid % nig) / gsz; return true;
    }
    __device__ __forceinline__ void a_ready(const Unit&) const {}
    __device__ __forceinline__ void done(const Unit&) const {}
};

__device__ __forceinline__ unsigned cvt_pk_bf16(float lo, float hi) { unsigned r; asm volatile("v_cvt_pk_bf16_f32 %0, %1, %2" : "=v"(r) : "v"(lo), "v"(hi)); return r; }
typedef float f32x2 __attribute__((ext_vector_type(2)));
__device__ __forceinline__ f32x2 gelu_pk(f32x2 v) {
    const f32x2 av = __builtin_elementwise_abs(v), d = av * 0.2316418882f + 1.0f;
    f32x2 t; t.x = __builtin_amdgcn_rcpf(d.x); t.y = __builtin_amdgcn_rcpf(d.y);
    f32x2 q = t * 0.5307027145f + (-0.7265760135f); q = q * t + 0.7107068705f; q = q * t + (-0.142248368f); q = q * t + 0.127414796f; q = q * t;
    const f32x2 s = (v * v) * (-0.72134752044f);
    f32x2 e; e.x = __builtin_amdgcn_exp2f(s.x); e.y = __builtin_amdgcn_exp2f(s.y);
    const f32x2 m = v * (q * e), r = v - m;
    f32x2 o; o.x = v.x < 0.f ? m.x : r.x; o.y = v.y < 0.f ? m.y : r.y; return o;
}

template <int ACT  > struct EpiBf16 {
    static constexpr bool PERM = true, AFTER_DRAIN = false; static_assert(ACT == 0 || ACT == 1, "EpiBf16: ACT is 0 (none) or 1 (gelu_pk)");
    bf16_t* O; int ldc; const float* bias; int split_cols; size_t split_stride; float scale0;
    __device__ __forceinline__ void operator()(const f32x4 (&acc)[2][2][4][2], const Unit& u, int wr, int wc, int fr, int fq) const {
        const int row0 = u.pm * BM + wr * 64 + fr; int colt = u.pn * BM; bf16_t* base = O;
        float sc = 1.f; if (split_cols) { const int t = colt / split_cols; base += (size_t)t * split_stride; colt -= t * split_cols; if (t == 0) sc = scale0; }
        const int col0 = colt + wc * 32 + 8 * fq, bcol0 = u.pn * BM + wc * 32 + 8 * fq;
        f32x4 bv[2][2];
#pragma unroll
        for (int bj = 0; bj < 2; ++bj)
#pragma unroll
            for (int n = 0; n < 2; ++n) bv[bj][n] = bias ? *(const f32x4*)(bias + bcol0 + bj * HALF + 4 * n) : (f32x4){0.f, 0.f, 0.f, 0.f};
#pragma unroll
        for (int ai = 0; ai < 2; ++ai)
#pragma unroll
            for (int m = 0; m < 4; ++m) { bf16_t* rowp = base + (size_t)(row0 + ai * HALF + m * 16) * ldc + col0;
#pragma unroll
                for (int bj = 0; bj < 2; ++bj) { f32x4 v0 = acc[ai][bj][m][0] + bv[bj][0], v1 = acc[ai][bj][m][1] + bv[bj][1];
                    if (ACT == 1) { f32x2 a = gelu_pk((f32x2){v0[0], v0[1]}), b = gelu_pk((f32x2){v0[2], v0[3]}), c = gelu_pk((f32x2){v1[0], v1[1]}), d = gelu_pk((f32x2){v1[2], v1[3]});
                        v0 = (f32x4){a.x, a.y, b.x, b.y}; v1 = (f32x4){c.x, c.y, d.x, d.y}; }
                    v0 = v0 * sc; v1 = v1 * sc; u32x4 w; w.x = cvt_pk_bf16(v0[0], v0[1]); w.y = cvt_pk_bf16(v0[2], v0[3]); w.z = cvt_pk_bf16(v1[0], v1[1]); w.w = cvt_pk_bf16(v1[2], v1[3]);
                    *(u32x4*)(rowp + bj * HALF) = w; } }
    }
};
template <class Epi, class Sched, bool ALIGN_EPI = false, bool SP2 = false>
__device__ __forceinline__ void gemm_phase(PG8_LAS unsigned char* lds, const Gemm g, const Sched& S, const Epi& E) {
    const int tid = threadIdx.x, wid = __builtin_amdgcn_readfirstlane(tid >> 6), lane = tid & 63, wr = wid >> 2, wc = wid & 3, fr = lane & 15, fq = lane >> 4;
    const int K = g.K, nt = K / BK;
    unsigned voffA[2], voffB[2];
#pragma unroll
    for (int i = 0; i < 2; ++i) { int R, C; stage_rc(tid * 16 + i * 8192, R, C); const int Rb = Epi::PERM ? ((R & ~31) + perm32(R & 31)) : R;
        voffA[i] = (unsigned)(R * K + C) * 2u; voffB[i] = (unsigned)(Rb * K + C) * 2u; }
    const size_t kstep = (size_t)(BK * 2);
    const size_t hstep = (size_t)HALF * K * 2;
    const size_t tstep = 2 * hstep;
    const unsigned ldsw = (unsigned)wid * 1024u;
    const int aoff = lds_byte(wr * 64 + fr, fq * 8), boff = lds_byte(wc * 32 + fr, fq * 8);
#define PG8_SA(b, h) (((b) * 2 + (h)) * HTB)
#define PG8_SB(b, h) ((4 + (b) * 2 + (h)) * HTB)
#define PG8_STAGE(bufoff, gbase, voff) do { _Pragma("unroll") for (int _i = 0; _i < 2; ++_i) \
        __builtin_amdgcn_global_load_lds((const unsigned*)((const char*)(gbase) + (voff)[_i]), (PG8_LAS unsigned*)(lds + (bufoff) + ldsw + _i * 8192), 16, 0, 0); } while (0)
#define PG8_LDA(dst, b, h) do { _Pragma("unroll") for (int m = 0; m < 4; ++m) _Pragma("unroll") for (int k = 0; k < 2; ++k) dst[m][k] = *(const PG8_LAS bf16x8*)(lds + PG8_SA(b, h) + aoff + m * 2048 + k * 1024); } while (0)
#define PG8_LDB(dst, b, h) do { _Pragma("unroll") for (int n = 0; n < 2; ++n) _Pragma("unroll") for (int k = 0; k < 2; ++k) dst[n][k] = *(const PG8_LAS bf16x8*)(lds + PG8_SB(b, h) + boff + n * 2048 + k * 1024); } while (0)
#define PG8_MMA(ai, bj, At, Bt) do { __builtin_amdgcn_s_setprio(1); _Pragma("unroll") for (int m = 0; m < 4; ++m) _Pragma("unroll") for (int n = 0; n < 2; ++n) _Pragma("unroll") for (int k = 0; k < 2; ++k) \
        acc[ai][bj][m][n] = __builtin_amdgcn_mfma_f32_16x16x32_bf16(Bt[n][k], At[m][k], acc[ai][bj][m][n], 0, 0, 0); __builtin_amdgcn_s_setprio(0); } while (0)
#define PG8_WAIT_V(n) asm volatile("s_waitcnt vmcnt(" #n ")" ::: "memory")
#define PG8_WAIT_L(n) asm volatile("s_waitcnt lgkmcnt(" #n ")" ::: "memory")
#define PG8_BAR __builtin_amdgcn_s_barrier()
#define PG8_SCHED __builtin_amdgcn_sched_barrier(0)
    Unit cur, nxt; int ui = 0;
    if (!S.next(0, cur)) return;
    f32x4 acc[2][2][4][2];
#pragma unroll
    for (int a = 0; a < 2; ++a)
#pragma unroll
        for (int b = 0; b < 2; ++b)
#pragma unroll
            for (int m = 0; m < 4; ++m)
#pragma unroll
                for (int n = 0; n < 2; ++n) acc[a][b][m][n] = (f32x4){0.f, 0.f, 0.f, 0.f};
    bf16x8 At[4][2], B0[2][2], B1[2][2];
    const char* cA = (const char*)g.A + (size_t)cur.pm * tstep; const char* cB = (const char*)g.Bt + (size_t)cur.pn * tstep;
    S.a_ready(cur);
    if constexpr (SP2) {
        PG8_STAGE(PG8_SB(0, 0), cB, voffB); PG8_STAGE(PG8_SB(0, 1), cB + hstep, voffB); PG8_STAGE(PG8_SA(0, 0), cA, voffA); PG8_STAGE(PG8_SA(0, 1), cA + hstep, voffA);
        if (wr == 1) PG8_BAR;
        PG8_WAIT_V(2); PG8_BAR;
        PG8_STAGE(PG8_SB(1, 0), cB + kstep, voffB); PG8_STAGE(PG8_SA(1, 0), cA + kstep, voffA); PG8_STAGE(PG8_SB(1, 1), cB + hstep + kstep, voffB);
        PG8_WAIT_V(6); PG8_BAR;
    } else {
        PG8_STAGE(PG8_SB(0, 0), cB, voffB); PG8_STAGE(PG8_SA(0, 0), cA, voffA); PG8_STAGE(PG8_SB(0, 1), cB + hstep, voffB); PG8_STAGE(PG8_SA(0, 1), cA + hstep, voffA);
        if (wr == 1) PG8_BAR;
        PG8_WAIT_V(4); PG8_BAR;
        PG8_STAGE(PG8_SB(1, 0), cB + kstep, voffB); PG8_STAGE(PG8_SA(1, 0), cA + kstep, voffA); PG8_STAGE(PG8_SB(1, 1), cB + hstep + kstep, voffB);
        PG8_WAIT_V(6); PG8_BAR;
    }
    for (;;) {
        const bool has_next = S.next(ui + 1, nxt);
        const char* nA = has_next ? (const char*)g.A + (size_t)nxt.pm * tstep : cA; const char* nB = has_next ? (const char*)g.Bt + (size_t)nxt.pn * tstep : cB;
        for (int t = 0; t < nt; t += 2) {
            const bool last = (t == nt - 2);
            const char* a1 = cA + (size_t)(t + 1) * kstep;
            const char* a2 = last ? nA : cA + (size_t)(t + 2) * kstep; const char* b2 = last ? nB : cB + (size_t)(t + 2) * kstep;
            const char* a3 = a2 + kstep; const char* b3 = b2 + kstep;
            if (last && has_next) S.a_ready(nxt);
            if constexpr (SP2) {
            PG8_LDB(B0, 0, 0); PG8_LDB(B1, 0, 1); PG8_SCHED; PG8_LDA(At, 0, 0); PG8_STAGE(PG8_SA(1, 1), a1 + hstep, voffA);
            PG8_WAIT_V(8); PG8_WAIT_L(0); PG8_BAR; PG8_MMA(0, 0, At, B0); PG8_MMA(0, 1, At, B1); PG8_BAR; PG8_SCHED;
            PG8_LDA(At, 0, 1); PG8_STAGE(PG8_SB(0, 0), b2, voffB); PG8_STAGE(PG8_SB(0, 1), b2 + hstep, voffB); PG8_STAGE(PG8_SA(0, 0), a2, voffA);
            PG8_WAIT_V(8); PG8_WAIT_L(0); PG8_BAR; PG8_MMA(1, 0, At, B0); PG8_MMA(1, 1, At, B1); PG8_BAR; PG8_SCHED;
            PG8_LDB(B0, 1, 0); PG8_LDB(B1, 1, 1); PG8_SCHED; PG8_LDA(At, 1, 0); PG8_STAGE(PG8_SA(0, 1), a2 + hstep, voffA);
            PG8_WAIT_V(8); PG8_WAIT_L(0); PG8_BAR; PG8_MMA(0, 0, At, B0); PG8_MMA(0, 1, At, B1); PG8_BAR; PG8_SCHED;
            PG8_LDA(At, 1, 1); PG8_STAGE(PG8_SB(1, 0), b3, voffB); PG8_STAGE(PG8_SB(1, 1), b3 + hstep, voffB); PG8_STAGE(PG8_SA(1, 0), a3, voffA);
            PG8_WAIT_V(8); PG8_WAIT_L(0); PG8_BAR; PG8_MMA(1, 0, At, B0); PG8_MMA(1, 1, At, B1); PG8_BAR; PG8_SCHED;
            } else {
            PG8_LDB(B0, 0, 0); PG8_SCHED; PG8_LDA(At, 0, 0); PG8_STAGE(PG8_SA(1, 1), a1 + hstep, voffA);
            PG8_WAIT_L(8); PG8_BAR; PG8_WAIT_L(0); PG8_MMA(0, 0, At, B0); PG8_BAR; PG8_SCHED;
            PG8_LDB(B1, 0, 1); PG8_STAGE(PG8_SB(0, 0), b2, voffB);
            PG8_BAR; PG8_WAIT_L(0); PG8_MMA(0, 1, At, B1); PG8_BAR;
            PG8_LDA(At, 0, 1); PG8_STAGE(PG8_SA(0, 0), a2, voffA);
            PG8_BAR; PG8_WAIT_L(0); PG8_MMA(1, 0, At, B0); PG8_BAR; PG8_SCHED;
            PG8_STAGE(PG8_SB(0, 1), b2 + hstep, voffB);
            PG8_WAIT_V(6); PG8_BAR; PG8_MMA(1, 1, At, B1); PG8_BAR;
            PG8_LDB(B0, 1, 0); PG8_SCHED; PG8_LDA(At, 1, 0); PG8_STAGE(PG8_SA(0, 1), a2 + hstep, voffA);
            PG8_WAIT_L(8); PG8_BAR; PG8_WAIT_L(0); PG8_MMA(0, 0, At, B0); PG8_BAR; PG8_SCHED;
            PG8_LDB(B1, 1, 1); PG8_STAGE(PG8_SB(1, 0), b3, voffB);
            PG8_BAR; PG8_WAIT_L(0); PG8_MMA(0, 1, At, B1); PG8_BAR;
            PG8_LDA(At, 1, 1); PG8_STAGE(PG8_SA(1, 0), a3, voffA);
            PG8_BAR; PG8_WAIT_L(0); PG8_MMA(1, 0, At, B0); PG8_BAR; PG8_SCHED;
            PG8_STAGE(PG8_SB(1, 1), b3 + hstep, voffB);
            PG8_WAIT_V(6); PG8_BAR; PG8_MMA(1, 1, At, B1); PG8_BAR;
            }
        }
        if constexpr (ALIGN_EPI) { if (wr == 0) PG8_BAR; }
        if constexpr (!Epi::AFTER_DRAIN) { E(acc, cur, wr, wc, fr, fq); S.done(cur); }
        if (!has_next) break;
#pragma unroll
        for (int a = 0; a < 2; ++a)
#pragma unroll
            for (int b = 0; b < 2; ++b)
#pragma unroll
                for (int m = 0; m < 4; ++m)
#pragma unroll
                    for (int n = 0; n < 2; ++n) acc[a][b][m][n] = (f32x4){0.f, 0.f, 0.f, 0.f};
        cur = nxt; cA = nA; cB = nB; ++ui;
        if constexpr (ALIGN_EPI) { if (wr == 1) PG8_BAR; }
    }
    PG8_WAIT_V(0);
    if constexpr (!ALIGN_EPI) { if (wr == 0) PG8_BAR; }
    PG8_BAR;
    if constexpr (Epi::AFTER_DRAIN) { E.fused(acc, cur, wr, wc, fr, fq, lds, wid, lane); S.done(cur); }
#undef PG8_SA
#undef PG8_SB
#undef PG8_STAGE
#undef PG8_LDA
#undef PG8_LDB
#undef PG8_MMA
#undef PG8_WAIT_V
#undef PG8_WAIT_L
#undef PG8_BAR
#undef PG8_SCHED
}
}

#define LAS __attribute__((address_space(3)))
typedef unsigned short bf16;
typedef short bf16x8 __attribute__((ext_vector_type(8)));
typedef short s16x4 __attribute__((ext_vector_type(4)));
typedef float f32x4 __attribute__((ext_vector_type(4)));
typedef float f32x16 __attribute__((ext_vector_type(16)));
typedef unsigned u32x4 __attribute__((ext_vector_type(4)));
typedef unsigned u32x2 __attribute__((ext_vector_type(2)));

constexpr int BATCH = 8, SEQ = 2048, DM = 1024, MROWS = BATCH * SEQ;
constexpr int AW = 768, DFF = 2816, NUP = 2 * DFF, NLAYER = 4;
constexpr float RMS_EPS = 1e-6f;
constexpr float LOG2E = 1.4426950408889634f;
constexpr float QSCALE = 0.125f * 1.4426950408889634f;
constexpr size_t MiB = 1u << 20;
constexpr size_t WS_ROPE = 64 * 1024;
constexpr size_t WS_WFT = 256 * 1024;
constexpr size_t WS_RS0 = 384 * 1024, WS_RS1 = 448 * 1024, WS_RS2 = 512 * 1024;
constexpr size_t WS_W = 1 * MiB;
constexpr size_t W_QK_A = WS_W, W_V_A = WS_W + 6 * MiB, W_O_A = WS_W + 9 * MiB, W_QK_B = WS_W + 12 * MiB, W_V_B = WS_W + 16 * MiB,
                 W_Q_B1 = WS_W + 18 * MiB, W_O_B = WS_W + 20 * MiB, W_UP = WS_W + 24 * MiB, W_DN = WS_W + 68 * MiB;
constexpr size_t WS_C2 = 91 * MiB, WS_FLOG = 92 * MiB, WS_LSE = 93 * MiB;
constexpr size_t WS_XN = 94 * MiB;
constexpr size_t WS_F = 126 * MiB;
constexpr size_t WS_G = 190 * MiB;
constexpr size_t G_QK_A = WS_G, G_VT_A = WS_G + 48 * MiB, G_O_A = WS_G + 72 * MiB, G_XP1 = WS_G + 96 * MiB, G_XP2 = WS_G + 128 * MiB;
constexpr size_t G_Q_B = WS_G, G_O_B = WS_G + 32 * MiB, G_K_B = WS_G + 96 * MiB, G_VT_B = WS_G + 128 * MiB;
constexpr size_t G_U = WS_G;
constexpr size_t WS_END = 352 * MiB;
constexpr int LDS_BYTES = 147456;
constexpr int LDS_MISC = 131072 + 320;
constexpr size_t WS_BAR = 16384;
constexpr int NPHASE = 1 + 9 * NLAYER;

__device__ __forceinline__ unsigned pk2(float lo, float hi) {
    typedef float f2 __attribute__((ext_vector_type(2))); typedef __bf16 b2 __attribute__((ext_vector_type(2)));
    f2 v = {lo, hi}; b2 b = __builtin_convertvector(v, b2); return __builtin_bit_cast(unsigned, b);
}
__device__ __forceinline__ float bf_lo(unsigned w) { return __uint_as_float(w << 16); }
__device__ __forceinline__ float bf_hi(unsigned w) { return __uint_as_float(w & 0xffff0000u); }
__device__ __forceinline__ float wave_sum(float v) {
#pragma unroll
    for (int o = 1; o < 64; o <<= 1) v += __shfl_xor(v, o);
    return v;
}
#define LDS_WAIT() asm volatile("s_waitcnt lgkmcnt(0)" ::: "memory")

namespace pg8 {
struct EpiF32 {
    static constexpr bool PERM = false, AFTER_DRAIN = false;
    float* O; int ldc;
    __device__ __forceinline__ void operator()(const f32x4 (&acc)[2][2][4][2], const Unit& u, int wr, int wc, int fr, int fq) const {
        const int row0 = u.pm * BM + wr * 64 + fr, col0 = u.pn * BM + wc * 32 + 4 * fq;
#pragma unroll
        for (int ai = 0; ai < 2; ++ai)
#pragma unroll
            for (int m = 0; m < 4; ++m) { float* rowp = O + (size_t)(row0 + ai * HALF + m * 16) * ldc + col0;
#pragma unroll
                for (int bj = 0; bj < 2; ++bj)
#pragma unroll
                    for (int n = 0; n < 2; ++n) *(f32x4*)(rowp + bj * HALF + n * 16) = acc[ai][bj][m][n]; }
    }
};
template <int CTRL> __device__ __forceinline__ float dppf(float old, float src) {
    return __int_as_float(__builtin_amdgcn_update_dpp(__float_as_int(old), __float_as_int(src), CTRL, 0xf, 0xf, false));
}
__device__ __forceinline__ float gelu_tanh(float x) {
    const float z = 0.7978845608028654f * (x + 0.044715f * x * x * x);
    const float e = __builtin_amdgcn_exp2f(-2.0f * 1.4426950408889634f * z);
    return x * __builtin_amdgcn_rcpf(1.0f + e);
}
struct EpiConvGlu {
    static constexpr bool PERM = true, AFTER_DRAIN = false;
    bf16_t* U; float* side; const float* cw; const float* cb; const float* rs;
    __device__ __forceinline__ void operator()(const f32x4 (&acc)[2][2][4][2], const Unit& u, int wr, int wc, int fr, int fq) const {
        const int chb = u.pn * HALF + wc * 32 + 8 * fq;
#pragma unroll
        for (int n = 0; n < 2; ++n) {
            const int ch = chb + 4 * n;
            const f32x4 wg0 = *(const f32x4*)(cw + ch), wg1 = *(const f32x4*)(cw + NUP + ch), wg2 = *(const f32x4*)(cw + 2 * NUP + ch), bg = *(const f32x4*)(cb + ch);
            const f32x4 wv0 = *(const f32x4*)(cw + DFF + ch), wv1 = *(const f32x4*)(cw + NUP + DFF + ch), wv2 = *(const f32x4*)(cw + 2 * NUP + DFF + ch), bv = *(const f32x4*)(cb + DFF + ch);
#pragma unroll
            for (int ai = 0; ai < 2; ++ai) {
                const int chunk = u.pm * 4 + ai * 2 + wr, rowbase = u.pm * BM + ai * HALF + wr * 64;
                float rr[4];
#pragma unroll
                for (int m = 0; m < 4; ++m) rr[m] = rs[rowbase + m * 16 + fr];
#pragma unroll
                for (int m = 0; m < 4; ++m) {
                    const f32x4 xg = acc[ai][0][m][n] * rr[m], xv = acc[ai][1][m][n] * rr[m];
                    if (m == 0 && fr < 2) { float* sp = side + (size_t)(chunk * 4 + fr) * NUP + ch; *(f32x4*)sp = xg; *(f32x4*)(sp + DFF) = xv; }
                    if (m == 3 && fr >= 14) { float* sp = side + (size_t)(chunk * 4 + fr - 12) * NUP + ch; *(f32x4*)sp = xg; *(f32x4*)(sp + DFF) = xv; }
                    f32x4 pg = (f32x4){0.f, 0.f, 0.f, 0.f}, pv = pg;
                    if (m > 0) { pg = acc[ai][0][m - 1][n] * rr[m - 1]; pv = acc[ai][1][m - 1][n] * rr[m - 1]; }
                    f32x4 g1, g2, v1, v2;
#pragma unroll
                    for (int e = 0; e < 4; ++e) {
                        g1[e] = dppf<0x111>(dppf<0x121>(0.f, pg[e]), xg[e]); g2[e] = dppf<0x112>(dppf<0x122>(0.f, pg[e]), xg[e]);
                        v1[e] = dppf<0x111>(dppf<0x121>(0.f, pv[e]), xv[e]); v2[e] = dppf<0x112>(dppf<0x122>(0.f, pv[e]), xv[e]);
                    }
                    const f32x4 cg = wg0 * g2 + wg1 * g1 + wg2 * xg + bg, cv = wv0 * v2 + wv1 * v1 + wv2 * xv + bv;
                    f32x4 o;
#pragma unroll
                    for (int e = 0; e < 4; ++e) o[e] = gelu_tanh(cg[e]) * cv[e];
                    if (!(m == 0 && fr < 2)) { u32x2 w; w.x = pk2(o[0], o[1]); w.y = pk2(o[2], o[3]); *(u32x2*)(U + (size_t)(rowbase + m * 16 + fr) * DFF + ch) = w; }
                }
            }
        }
    }
};
template <bool MODE_A> struct EpiHeads {
    static constexpr bool PERM = true, AFTER_DRAIN = false;
    bf16_t* Qo; bf16_t* Ko; int nhq; const float* rope; const float* rs;
    __device__ __forceinline__ void operator()(const f32x4 (&acc)[2][2][4][2], const Unit& u, int wr, int wc, int fr, int fq) const {
#pragma unroll
        for (int bj = 0; bj < 2; ++bj) {
            const int c = u.pn * BM + bj * HALF + wc * 32 + 8 * fq, hq = c >> 6, d = c & 63;
            const bool isK = hq >= nhq; const int head = isK ? hq - nhq : hq;
            bf16_t* base = (isK ? Ko : Qo) + (size_t)head * (MROWS * 64) + d;
            const int sh = MODE_A ? 2 * (head >> 2) : 0;
#pragma unroll
            for (int ai = 0; ai < 2; ++ai)
#pragma unroll
                for (int m = 0; m < 4; ++m) {
                    const int row = u.pm * BM + ai * HALF + wr * 64 + m * 16 + fr, t = row & (SEQ - 1);
                    const int prow = MODE_A ? ((row & ~(SEQ - 1)) + ((t & ((1 << sh) - 1)) << (11 - sh)) + (t >> sh)) : row;
                    const float rsr = rs[row];
                    f32x4 v0 = acc[ai][bj][m][0] * rsr, v1 = acc[ai][bj][m][1] * rsr;
                    if (MODE_A && (wc & 1) == 0) {
                        const float* ct = rope + t * 8;
                        const f32x4 c0 = *(const f32x4*)ct, c1 = *(const f32x4*)(ct + 4), s0 = *(const f32x4*)(ct + SEQ * 8), s1 = *(const f32x4*)(ct + SEQ * 8 + 4);
                        f32x4 p0, p1;
#pragma unroll
                        for (int e = 0; e < 4; ++e) { p0[e] = __shfl_xor(v0[e], 16); p1[e] = __shfl_xor(v1[e], 16); }
                        if (fq == 0) { v0 = v0 * c0 - p0 * s0; v1 = v1 * c1 - p1 * s1; }
                        else if (fq == 1) { v0 = v0 * c0 + p0 * s0; v1 = v1 * c1 + p1 * s1; }
                    }
                    u32x4 w; w.x = pk2(v0[0], v0[1]); w.y = pk2(v0[2], v0[3]); w.z = pk2(v1[0], v1[1]); w.w = pk2(v1[2], v1[3]);
                    *(u32x4*)(base + (size_t)prow * 64) = w;
                }
        }
    }
};
struct EpiVT {
    static constexpr bool PERM = true, AFTER_DRAIN = false;
    bf16_t* O; const float* rsc;
    __device__ __forceinline__ void operator()(const f32x4 (&acc)[2][2][4][2], const Unit& u, int wr, int wc, int fr, int fq) const {
        f32x4 rc[2][2];
#pragma unroll
        for (int bj = 0; bj < 2; ++bj) { const int col = u.pn * BM + bj * HALF + wc * 32 + 8 * fq; rc[bj][0] = *(const f32x4*)(rsc + col); rc[bj][1] = *(const f32x4*)(rsc + col + 4); }
#pragma unroll
        for (int ai = 0; ai < 2; ++ai)
#pragma unroll
            for (int m = 0; m < 4; ++m) { const int row = u.pm * BM + ai * HALF + wr * 64 + m * 16 + fr;
#pragma unroll
                for (int bj = 0; bj < 2; ++bj) { const int col = u.pn * BM + bj * HALF + wc * 32 + 8 * fq;
                    const f32x4 v0 = acc[ai][bj][m][0] * rc[bj][0], v1 = acc[ai][bj][m][1] * rc[bj][1];
                    u32x4 w; w.x = pk2(v0[0], v0[1]); w.y = pk2(v0[2], v0[3]); w.z = pk2(v1[0], v1[1]); w.w = pk2(v1[2], v1[3]);
                    *(u32x4*)(O + ((size_t)(((row >> 6) * 256 + (col >> 6)) * 64 + (row & 63))) * 64 + (col & 63)) = w; } }
    }
};
}

__device__ __forceinline__ void wt_item(const float* W, int ldw, int K, int k0, int ncol0, bf16* WT, int out_row0, const float* gain, float scale, LAS float* scr, int lane) {
    float wv[32];
#pragma unroll
    for (int i = 0; i < 32; ++i) wv[i] = W[(size_t)(k0 + 2 * i + (lane >> 5)) * ldw + ncol0 + (lane & 31)];
#pragma unroll
    for (int i = 0; i < 32; ++i) { const int kk = 2 * i + (lane >> 5); const float g = gain ? gain[k0 + kk] * scale : scale;
        scr[kk * 33 + (lane & 31)] = wv[i] * g; }
    LDS_WAIT();
    const int c = lane & 7;
#pragma unroll
    for (int j = 0; j < 4; ++j) { const int n = (lane >> 3) + 8 * j; const LAS float* s = scr + (8 * c) * 33 + n;
        u32x4 o; o.x = pk2(s[0 * 33], s[1 * 33]); o.y = pk2(s[2 * 33], s[3 * 33]); o.z = pk2(s[4 * 33], s[5 * 33]); o.w = pk2(s[6 * 33], s[7 * 33]);
        *(u32x4*)(WT + (size_t)(out_row0 + n) * K + k0 + 8 * c) = o; }
    LDS_WAIT();
}
__device__ __forceinline__ void conv_mat(const float* W, int ldw, int K, int col0, int ncols, bf16* WT, int mode, const float* gain, float scale,
                                         LAS float* scr, int gw, int NGW, int lane, int& off) {
    const int nnb = ncols / 32, nitems = (K / 64) * nnb;
    for (int it = (gw + NGW - off) % NGW; it < nitems; it += NGW) {
        const int kb = it / nnb, nb = it % nnb, n0 = 32 * nb;
        int out_row0 = n0;
        if (mode == 1) { const int bj = n0 / DFF, ch0 = n0 % DFF; out_row0 = 256 * (ch0 / 128) + 128 * bj + (ch0 % 128); }
        wt_item(W, ldw, K, 64 * kb, col0 + n0, WT, out_row0, gain, scale, scr, lane);
    }
    off = (off + nitems) % NGW;
}

__device__ __forceinline__ void sincos_f64(float ang, float& sn, float& cs) {
    const double x = (double)ang; const double k = __builtin_rint(x * 0.63661977236758134308);
    double r = __builtin_fma(-k, 1.57079632679489655800, x); r = __builtin_fma(-k, 6.12323399573676603587e-17, r);
    const double r2 = r * r;
    double s = 1.6059043836821613e-10; s = s * r2 - 2.5052108385441720e-08; s = s * r2 + 2.7557319223985893e-06; s = s * r2 - 1.9841269841269841e-04;
    s = s * r2 + 8.3333333333333332e-03; s = s * r2 - 1.6666666666666666e-01; s = s * r2 * r + r;
    double c = -1.1470745597729725e-11; c = c * r2 + 2.0876756987868100e-09; c = c * r2 - 2.7557319223985888e-07; c = c * r2 + 2.4801587301587302e-05;
    c = c * r2 - 1.3888888888888889e-03; c = c * r2 + 4.1666666666666664e-02; c = c * r2 - 0.5; c = c * r2 + 1.0;
    const int q = ((int)k) & 3;
    const double ss = (q == 0) ? s : (q == 1) ? c : (q == 2) ? -s : -c;
    const double cc = (q == 0) ? c : (q == 1) ? -s : (q == 2) ? -c : s;
    sn = (float)ss; cs = (float)cc;
}

template <int MODE>
__device__ __forceinline__ void row_phase(const float* src, const float* gain, bf16* hb, float* outf, bf16* xp1, bf16* xp2, float* rs0, float* rs1, float* rs2, bool want_perm,
                                          bool want_forget, const LAS float* wft, const float* bfg, float* flog, int gw, int NGW, int lane) {
    for (int m = gw; m < MROWS; m += NGW) {
        f32x4 v[4]; float ss = 0.f;
#pragma unroll
        for (int j = 0; j < 4; ++j) {
            if (MODE == 1) { const u32x2 w = *(const u32x2*)((const bf16*)src + (size_t)m * DM + 4 * lane + 256 * j); v[j] = (f32x4){bf_lo(w.x), bf_hi(w.x), bf_lo(w.y), bf_hi(w.y)}; }
            else v[j] = *(const f32x4*)(src + (size_t)m * DM + 4 * lane + 256 * j);
            ss += (v[j].x * v[j].x + v[j].y * v[j].y) + (v[j].z * v[j].z + v[j].w * v[j].w); }
        if (MODE == 1) {
            const float rs = 1.0f / sqrtf(wave_sum(ss) * (1.0f / DM) + RMS_EPS); ss = 0.f;
#pragma unroll
            for (int j = 0; j < 4; ++j) { const f32x4 g = *(const f32x4*)(gain + 4 * lane + 256 * j); const u32x2 hw = *(const u32x2*)(hb + (size_t)m * DM + 4 * lane + 256 * j);
                const f32x4 ho = (f32x4){bf_lo(hw.x), bf_hi(hw.x), bf_lo(hw.y), bf_hi(hw.y)};
                v[j] = ho + v[j] * rs * g; ss += (v[j].x * v[j].x + v[j].y * v[j].y) + (v[j].z * v[j].z + v[j].w * v[j].w); }
        }
        if (outf) {
#pragma unroll
            for (int j = 0; j < 4; ++j) *(f32x4*)(outf + (size_t)m * DM + 4 * lane + 256 * j) = v[j];
        } else {
            const float rs2v = 1.0f / sqrtf(wave_sum(ss) * (1.0f / DM) + RMS_EPS);
            u32x2 w[4];
#pragma unroll
            for (int j = 0; j < 4; ++j) { w[j].x = pk2(v[j].x, v[j].y); w[j].y = pk2(v[j].z, v[j].w); *(u32x2*)(hb + (size_t)m * DM + 4 * lane + 256 * j) = w[j]; }
            if (lane == 0) rs0[m] = rs2v;
            if (want_perm) {
                const int b = m / SEQ, t = m % SEQ;
                const size_t m1 = (size_t)b * SEQ + (t & 3) * 512 + (t >> 2), m2 = (size_t)b * SEQ + (t & 15) * 128 + (t >> 4);
#pragma unroll
                for (int j = 0; j < 4; ++j) { *(u32x2*)(xp1 + m1 * DM + 4 * lane + 256 * j) = w[j]; *(u32x2*)(xp2 + m2 * DM + 4 * lane + 256 * j) = w[j]; }
                if (lane == 0) { rs1[m1] = rs2v; rs2[m2] = rs2v; }
            }
            if (want_forget) {
                float mine = 0.f;
#pragma unroll 4
                for (int hd = 0; hd < 16; ++hd) { float a = 0.f;
#pragma unroll
                    for (int j = 0; j < 4; ++j) { const f32x4 wv = *(const LAS f32x4*)(wft + hd * DM + 4 * lane + 256 * j); a += (v[j].x * wv.x + v[j].y * wv.y) + (v[j].z * wv.z + v[j].w * wv.w); }
                    a = wave_sum(a); if (lane == hd) mine = a; }
                if (lane < 16) flog[(size_t)m * 16 + lane] = mine * rs2v + bfg[lane];
            }
        }
    }
}

__device__ __forceinline__ float log_sigmoid(float x) { return fminf(x, 0.f) - logf(1.0f + expf(-fabsf(x))); }
__device__ __forceinline__ void scan_unit(const float* flog, float* c2, int bh, int lane) {
    const int b = bh >> 4, hd = bh & 15; const float* fp = flog + ((size_t)b * SEQ + 32 * lane) * 16 + hd;
    float tot = 0.f;
    for (int i = 0; i < 32; ++i) tot += log_sigmoid(fp[i * 16]);
    float inc = tot;
#pragma unroll
    for (int o = 1; o < 64; o <<= 1) { const float t = __shfl_up(inc, o); if (lane >= o) inc += t; }
    float run = inc - tot;
    float* cp = c2 + (size_t)bh * SEQ + 32 * lane;
    for (int i = 0; i < 32; ++i) { run += log_sigmoid(fp[i * 16]); cp[i] = run * LOG2E; }
}

struct AttnHalf {
    const bf16* Q; const bf16* K; const bf16* VT; bf16* O; float* lse; const float* cq;
    int q_stride, k_stride, vt_pitch, o_stride, lse_stride;
    int q0, kv_begin, nback, pos0, pos_step;
};
constexpr int AT_PITCH = 144, AT_K = 0, AT_V = 9216, AT_CK = 18432, AT_BUF = 18688, AT_HALF = 2 * AT_BUF;
__device__ __forceinline__ int crow(int r, int hi) { return (r & 3) + 8 * (r >> 2) + 4 * hi; }
__device__ __forceinline__ void rope16v(u32x4& a, u32x4& b, const f32x4 c0, const f32x4 c1, const f32x4 s0, const f32x4 s1) {
#define RC_(k) ((k) < 4 ? c0[(k) & 3] : c1[(k) & 3])
#define RS_(k) ((k) < 4 ? s0[(k) & 3] : s1[(k) & 3])
    u32x4 oa, ob;
#pragma unroll
    for (int i = 0; i < 4; ++i) {
        const float x1l = bf_lo(a[i]), x1h = bf_hi(a[i]), x2l = bf_lo(b[i]), x2h = bf_hi(b[i]);
        oa[i] = pk2(x1l * RC_(2 * i) - x2l * RS_(2 * i), x1h * RC_(2 * i + 1) - x2h * RS_(2 * i + 1));
        ob[i] = pk2(x2l * RC_(2 * i) + x1l * RS_(2 * i), x2h * RC_(2 * i + 1) + x1h * RS_(2 * i + 1));
    }
    a = oa; b = ob;
#undef RC_
#undef RS_
}
__device__ __forceinline__ void rope16(u32x4& a, u32x4& b, const float* ct, const float* st) {
    rope16v(a, b, *(const f32x4*)ct, *(const f32x4*)(ct + 4), *(const f32x4*)st, *(const f32x4*)(st + 4));
}

__device__ __forceinline__ float xhalf_max(float v) { auto rr = __builtin_amdgcn_permlane32_swap(__float_as_uint(v), __float_as_uint(v), false, false); return fmaxf(__uint_as_float(rr[0]), __uint_as_float(rr[1])); }
__device__ __forceinline__ float xhalf_sum(float v) { auto rr = __builtin_amdgcn_permlane32_swap(__float_as_uint(v), __float_as_uint(v), false, false); return __uint_as_float(rr[0]) + __uint_as_float(rr[1]); }
template <int QB, bool ROPE, bool BIAS>
__device__ __forceinline__ void attn_super(const AttnHalf& U, int ntiles, LAS unsigned char* ldsbase, const float* ropetab, int tid) {
    const int lane = tid & 63, r32 = lane & 31, hi = lane >> 5, tidh = tid & 255, waveh = (tid >> 6) & 3, half = tid >> 8;
    LAS unsigned char* lds = ldsbase + half * AT_HALF;
    const int qlo = U.q0 + waveh * 32 * QB, qhi = qlo + 32 * QB - 1;
    bf16x8 qf[QB][4]; float cqv[QB];
#pragma unroll
    for (int qb = 0; qb < QB; ++qb) {
        const int qi = qlo + 32 * qb + r32; const bf16* src = U.Q + (size_t)qi * U.q_stride;
#pragma unroll
        for (int d0 = 0; d0 < 4; ++d0) qf[qb][d0] = *(const bf16x8*)(src + 16 * d0 + 8 * hi);
        if (ROPE) { u32x4 a = *(const u32x4*)src, b = *(const u32x4*)(src + 8); const int pos = U.pos0 + qi * U.pos_step;
            rope16(a, b, ropetab + pos * 8, ropetab + SEQ * 8 + pos * 8); qf[qb][0] = __builtin_bit_cast(bf16x8, hi ? b : a); }
        cqv[qb] = BIAS ? U.cq[qi] : 0.f;
    }
    f32x16 OT[QB][2]; float mrun[QB], lrun[QB];
#pragma unroll
    for (int qb = 0; qb < QB; ++qb) { mrun[qb] = -1e30f; lrun[qb] = 0.f;
#pragma unroll
        for (int dh = 0; dh < 2; ++dh)
#pragma unroll
            for (int r = 0; r < 16; ++r) OT[qb][dh][r] = 0.f; }
    u32x4 kr0, kr1, vr0, vr1; f32x4 ckr = (f32x4){0.f, 0.f, 0.f, 0.f};
    f32x4 rc0 = ckr, rc1 = ckr, rs0 = ckr, rs1 = ckr;
    const int trow = tidh >> 2, tseg = tidh & 3;
#define AT_LOAD(t) do { const int kv0_ = U.kv_begin + 64 * (t); const int kvc_ = kv0_ < 0 ? 0 : kv0_; \
        const bf16* ks_ = U.K + (size_t)(kvc_ + trow) * U.k_stride + 16 * tseg; kr0 = *(const u32x4*)ks_; kr1 = *(const u32x4*)(ks_ + 8); \
        const bf16* vs_ = U.VT + (size_t)(kvc_ >> 6) * 4096 + trow * 64 + 16 * tseg; vr0 = *(const u32x4*)vs_; vr1 = *(const u32x4*)(vs_ + 8); \
        if (BIAS) { if (tidh < 16) ckr = *(const f32x4*)(U.cq + kvc_ + 4 * tidh); } \
        if (ROPE) { if (tseg == 0) { const int pos_ = U.pos0 + (kvc_ + trow) * U.pos_step; const float* ct_ = ropetab + pos_ * 8; \
            rc0 = *(const f32x4*)ct_; rc1 = *(const f32x4*)(ct_ + 4); rs0 = *(const f32x4*)(ct_ + SEQ * 8); rs1 = *(const f32x4*)(ct_ + SEQ * 8 + 4); } } } while (0)
#define AT_STORE(buf) do { LAS unsigned char* b_ = lds + (buf) * AT_BUF; \
        if (ROPE) { if (tseg == 0) rope16v(kr0, kr1, rc0, rc1, rs0, rs1); } \
        *(LAS u32x4*)(b_ + AT_K + trow * AT_PITCH + tseg * 32) = kr0; *(LAS u32x4*)(b_ + AT_K + trow * AT_PITCH + tseg * 32 + 16) = kr1; \
        *(LAS u32x4*)(b_ + AT_V + trow * AT_PITCH + tseg * 32) = vr0; *(LAS u32x4*)(b_ + AT_V + trow * AT_PITCH + tseg * 32 + 16) = vr1; \
        if (BIAS) { if (tidh < 16) *(LAS f32x4*)(b_ + AT_CK + 16 * tidh) = ckr; } } while (0)
    AT_LOAD(0); AT_STORE(0);
    __syncthreads();
    for (int t = 0; t < ntiles; ++t) {
        if (t + 1 < ntiles) AT_LOAD(t + 1);
        const LAS unsigned char* bb = lds + (t & 1) * AT_BUF;
        const int kv0 = U.kv_begin + 64 * t;
#pragma unroll
        for (int kb = 0; kb < 2; ++kb) {
            const int kvb = kv0 + 32 * kb;
            if (kvb < 0 || kvb > qhi || qlo - (kvb + 31) > U.nback) continue;
            bf16x8 kf[4];
#pragma unroll
            for (int d0 = 0; d0 < 4; ++d0) kf[d0] = *(const LAS bf16x8*)(bb + AT_K + (32 * kb + r32) * AT_PITCH + (16 * d0 + 8 * hi) * 2);
            bf16x8 pa[QB][2];
#pragma unroll
            for (int qb = 0; qb < QB; ++qb) {
                f32x4 ck4[4];
                if (BIAS) {
#pragma unroll
                    for (int jj = 0; jj < 4; ++jj) ck4[jj] = *(const LAS f32x4*)(bb + AT_CK + (32 * kb + 8 * jj + 4 * hi) * 4);
                    if (QB > 1) asm volatile("" ::: "memory");
                }
                f32x16 S;
#pragma unroll
                for (int r = 0; r < 16; ++r) S[r] = BIAS ? (cqv[qb] - ck4[r >> 2][r & 3]) : 0.f;
#pragma unroll
                for (int d0 = 0; d0 < 4; ++d0) S = __builtin_amdgcn_mfma_f32_32x32x16_bf16(kf[d0], qf[qb][d0], S, 0, 0, 0);
                const int qb0 = qlo + 32 * qb, qi = qb0 + r32;
                if (kvb + 31 > qb0 || qb0 + 31 - kvb > U.nback) {
#pragma unroll
                    for (int r = 0; r < 16; ++r) { const int kvj = kvb + crow(r, hi); const bool ok = (kvj <= qi) && (qi - kvj <= U.nback); S[r] = ok ? S[r] : -INFINITY; }
                }
                float mx = S[0];
#pragma unroll
                for (int r = 1; r < 16; ++r) mx = fmaxf(mx, S[r]);
                mx = xhalf_max(mx);
                const float mnew = fmaxf(mrun[qb], mx);
                const float alpha = __builtin_amdgcn_exp2f(mrun[qb] - mnew);
                if (__any(mnew > mrun[qb])) {
#pragma unroll
                    for (int dh = 0; dh < 2; ++dh)
#pragma unroll
                        for (int r = 0; r < 16; ++r) OT[qb][dh][r] *= alpha;
                }
                mrun[qb] = mnew;
                float ps = 0.f;
#pragma unroll
                for (int r = 0; r < 16; ++r) { S[r] = __builtin_amdgcn_exp2f(S[r] - mnew); ps += S[r]; }
                lrun[qb] = lrun[qb] * alpha + ps;
#pragma unroll
                for (int ks = 0; ks < 2; ++ks) { u32x4 w; w.x = pk2(S[8 * ks], S[8 * ks + 1]); w.y = pk2(S[8 * ks + 2], S[8 * ks + 3]); w.z = pk2(S[8 * ks + 4], S[8 * ks + 5]); w.w = pk2(S[8 * ks + 6], S[8 * ks + 7]);
                    pa[qb][ks] = __builtin_bit_cast(bf16x8, w); }
            }
#pragma unroll
            for (int ks = 0; ks < 2; ++ks)
#pragma unroll
                for (int dh = 0; dh < 2; ++dh) {
                    const LAS unsigned char* vp = bb + AT_V + (32 * dh + r32) * AT_PITCH + (32 * kb + 16 * ks + 4 * hi) * 2;
                    const s16x4 lo = *(const LAS s16x4*)vp, hi4 = *(const LAS s16x4*)(vp + 16);
                    const bf16x8 vf = (bf16x8){lo[0], lo[1], lo[2], lo[3], hi4[0], hi4[1], hi4[2], hi4[3]};
#pragma unroll
                    for (int qb = 0; qb < QB; ++qb) OT[qb][dh] = __builtin_amdgcn_mfma_f32_32x32x16_bf16(vf, pa[qb][ks], OT[qb][dh], 0, 0, 0);
                }
        }
        if (t + 1 < ntiles) AT_STORE((t + 1) & 1);
        __syncthreads();
    }
#undef AT_LOAD
#undef AT_STORE
#pragma unroll
    for (int qb = 0; qb < QB; ++qb) {
        const float l = xhalf_sum(lrun[qb]); const float inv = 1.0f / l;
        const int qi = qlo + 32 * qb + r32; bf16* op = U.O + (size_t)qi * U.o_stride;
#pragma unroll
        for (int dh = 0; dh < 2; ++dh)
#pragma unroll
            for (int r4 = 0; r4 < 4; ++r4) { u32x2 w; w.x = pk2(OT[qb][dh][4 * r4] * inv, OT[qb][dh][4 * r4 + 1] * inv); w.y = pk2(OT[qb][dh][4 * r4 + 2] * inv, OT[qb][dh][4 * r4 + 3] * inv);
                *(u32x2*)(op + 32 * dh + 8 * r4 + 4 * hi) = w; }
        if (U.lse && hi == 0) U.lse[(size_t)qi * U.lse_stride] = mrun[qb] + __builtin_amdgcn_logf(l);
    }
}

#define XB_TMO      128
#define XB_XCNT(j)  (256  + 64 * (j))
#define XB_XSUB(j)  (1280 + 64 * (j))
#define XB_XGEN(j)  (2304 + 64 * (j))
#define XB_TOP      3328
#define XB_TOPGEN   3392
#define XCD_BAR_WORDS 3456
#define XB_SPIN_CAP (1u << 18)

__device__ __forceinline__ unsigned xb_ld(unsigned* p)              { return __hip_atomic_load(p, __ATOMIC_RELAXED, __HIP_MEMORY_SCOPE_AGENT); }
__device__ __forceinline__ unsigned xb_add(unsigned* p, unsigned v) { return __hip_atomic_fetch_add(p, v, __ATOMIC_RELAXED, __HIP_MEMORY_SCOPE_AGENT); }
__device__ __forceinline__ unsigned xb_xcc_id() { return (unsigned)__builtin_amdgcn_s_getreg((3 << 11) | 20) & 0xFu; }
#define XB_SPIN(cond, bar) do { unsigned _sp = 0; while (cond) { __builtin_amdgcn_s_sleep(1); \
    if ((++_sp & 255u) == 0u) { if (xb_ld(&(bar)[XB_TMO])) break; if (_sp > XB_SPIN_CAP) { atomicAdd(&(bar)[XB_TMO], 1u); break; } } } } while (0)

struct XcdBarrier {
    unsigned* bar; unsigned x;
    volatile LAS unsigned* st;
};

__device__ __forceinline__ XcdBarrier xcd_barrier_post(unsigned* bar, volatile LAS unsigned* st) {
    XcdBarrier b; b.bar = bar; b.x = xb_xcc_id(); b.st = st;
    if (threadIdx.x == 0) (void)xb_add(&bar[XB_XCNT(b.x)], 1u);
    return b;
}
__device__ __forceinline__ void xcd_barrier_complete(unsigned* bar, unsigned x, unsigned& nloc, unsigned& nx) {
    const unsigned G = gridDim.x * gridDim.y * gridDim.z;
    unsigned sum, cnt, mine, sp = 0u;
    for (;;) {
        sum = 0u; cnt = 0u; mine = 0u;
#pragma unroll
        for (unsigned j = 0; j < 16; ++j) { const unsigned c = xb_ld(&bar[XB_XCNT(j)]); sum += c; cnt += (c > 0u) ? 1u : 0u; mine = (j == x) ? c : mine; }
        if (sum == G) break;
        __builtin_amdgcn_s_sleep(1);
        if ((++sp & 255u) == 0u) { if (xb_ld(&bar[XB_TMO])) break; if (sp > XB_SPIN_CAP) { atomicAdd(&bar[XB_TMO], 1u); break; } }
    }
    nloc = mine > 0u ? mine : 1u; nx = cnt > 0u ? cnt : 1u;
}

__device__ __forceinline__ void xcd_barrier(const XcdBarrier& b) {
    asm volatile("s_waitcnt vmcnt(0)" ::: "memory");
    __syncthreads();
    if (threadIdx.x == 0) {
        unsigned* bar = b.bar;
        __builtin_amdgcn_s_waitcnt(0);
        unsigned nloc = b.st[0], nx = b.st[1];
        if (nloc == 0u) { xcd_barrier_complete(bar, b.x, nloc, nx); b.st[0] = nloc; b.st[1] = nx; }
        const unsigned old = xb_add(&bar[XB_XSUB(b.x)], 1u);
        const unsigned gen = old / nloc;
        if (old + 1u == (gen + 1u) * nloc) {
            __builtin_amdgcn_fence(__ATOMIC_RELEASE, "agent");
            asm volatile("s_waitcnt vmcnt(0)" ::: "memory");
            const unsigned og = xb_add(&bar[XB_TOP], 1u);
            const unsigned tg = og / nx;
            if (og + 1u == (tg + 1u) * nx) xb_add(&bar[XB_TOPGEN], 1u);
            else XB_SPIN(xb_ld(&bar[XB_TOPGEN]) == tg, bar);
            __builtin_amdgcn_fence(__ATOMIC_ACQUIRE, "agent");
            xb_add(&bar[XB_XGEN(b.x)], 1u);
            asm volatile("s_waitcnt vmcnt(0)" ::: "memory");
        } else {
            XB_SPIN(xb_ld(&bar[XB_XGEN(b.x)]) == gen, bar);
            __builtin_amdgcn_fence(__ATOMIC_ACQUIRE, "agent");
            asm volatile("s_waitcnt vmcnt(0)" ::: "memory");
        }
    }
    __syncthreads();
}

struct Args { const float* in[13]; float* out; unsigned char* ws; float invf[8]; int ph_lo, ph_hi; };
enum { IN_X = 0, IN_GAINS, IN_WQKV_A, IN_WO_A, IN_WQ_B, IN_WO_B, IN_KVNORM, IN_WKVF, IN_BF, IN_WUP, IN_CONVW, IN_CONVB, IN_WDOWN };

__host__ __device__ inline bool phase_noop(int ph) { if (ph == 0) return false; const int l = (ph - 1) / 9, s = (ph - 1) % 9; return (s == 2 && l >= 2) || s == 6; }

#define PH_LOCALS() \
    int tid = threadIdx.x; asm volatile("" : "+v"(tid)); \
    const int lane = tid & 63, wave = __builtin_amdgcn_readfirstlane(tid >> 6); \
    const int G = gridDim.x, bx = blockIdx.x, gw = bx * 8 + wave, NGW = G * 8; \
    unsigned char* ws = a.ws; float* h = a.out; \
    bf16* xn = (bf16*)(ws + WS_XN); float* Fb = (float*)(ws + WS_F); \
    const float* gains = a.in[IN_GAINS]; const float* ropetab = (const float*)(ws + WS_ROPE); \
    (void)lane; (void)wave; (void)gw; (void)NGW; (void)h; (void)xn; (void)Fb; (void)gains; (void)ropetab; (void)G; (void)bx
#ifndef PROBE_REP
#define PROBE_REP 0
#endif
#ifndef PROBE_SYNC2
#define PROBE_SYNC2 0
#endif
#ifndef PROBE_LAYERS
#define PROBE_LAYERS 0xF
#endif
__host__ __device__ constexpr int phase_reps_raw(int k) { return (k == 0) ? (((PROBE_REP >> 9) & 1) ? 2 : 1) : ((((PROBE_REP >> ((k - 1) % 9)) & 1) && ((PROBE_LAYERS >> ((k - 1) / 9)) & 1)) ? 2 : 1); }
__host__ __device__ constexpr bool phase_is_gemm(int k) { return k > 0 && (((k - 1) % 9) == 0 || ((k - 1) % 9) == 3 || ((k - 1) % 9) == 5 || ((k - 1) % 9) == 7); }
__host__ __device__ constexpr int phase_reps(int k) { return phase_is_gemm(k) ? 1 : phase_reps_raw(k); }
#define PH_BEGIN(k) if (a.ph_lo <= (k) && (k) < a.ph_hi) { for (int rep_ = 0; rep_ < phase_reps(k); ++rep_) { if (rep_) grid.sync(); PH_LOCALS();
#define SEAM1(k) do { if ((k) == 0) { grid.sync(); (void)xcd_barrier_post((unsigned*)(a.ws + WS_BAR), (volatile LAS unsigned*)(lds + LDS_MISC)); } \
    else { XcdBarrier b_; b_.bar = (unsigned*)(a.ws + WS_BAR); b_.x = xb_xcc_id(); b_.st = (volatile LAS unsigned*)(lds + LDS_MISC); xcd_barrier(b_); } } while (0)
#define PH_END(k) } if ((k) + 1 < a.ph_hi) { SEAM1(k); if (PROBE_SYNC2 && (k) != 0) SEAM1(k); } }

template <int L>
__device__ __forceinline__ void run_layer(const Args& a, LAS unsigned char* lds, cg::grid_group& grid) {
    constexpr int base = 1 + 9 * L; constexpr bool isA = L < 2; constexpr int l = L;
    PH_BEGIN(base + 0)
        if (L == 2) { if (gw < BATCH * 16) scan_unit((const float*)(ws + WS_FLOG), (float*)(ws + WS_C2), gw, lane); }
        {
            pg8::Gemm g;
            if (isA) g = pg8::Gemm{xn, (const bf16*)(ws + W_QK_A + l * 3 * MiB), MROWS, 1536, DM};
            else if (L == 2) g = pg8::Gemm{xn, (const bf16*)(ws + W_QK_B), MROWS, 2048, DM};
            else g = pg8::Gemm{xn, (const bf16*)(ws + W_Q_B1), MROWS, DM, DM};
            pg8::StaticOrder S; S.init(g.M, g.N, G, bx); S.reps = phase_reps_raw(base + 0);
            pg8::EpiHeads<isA> E{isA ? (bf16*)(ws + G_QK_A) : (bf16*)(ws + G_Q_B), isA ? (bf16*)(ws + G_QK_A + 24 * MiB) : (bf16*)(ws + G_K_B), isA ? 12 : 16, ropetab, (const float*)(ws + WS_RS0)};
            pg8::gemm_phase<pg8::EpiHeads<isA>, pg8::StaticOrder, true, true>(lds, g, S, E);
            __syncthreads();
        }
        constexpr int nvt = isA ? 3 : (L == 2 ? 1 : 0);
        for (int j = 0; j < nvt; ++j) {
            pg8::Gemm g; bf16* O; int rot = 0;
            if (isA) { const bf16* Bt = (j == 0) ? xn : (j == 1) ? (const bf16*)(ws + G_XP1) : (const bf16*)(ws + G_XP2);
                g = pg8::Gemm{(const bf16*)(ws + W_V_A + l * 3 * MiB / 2) + (size_t)j * 256 * DM, Bt, 256, MROWS, DM};
                O = (bf16*)(ws + G_VT_A) + (size_t)j * 256 * MROWS; rot = (j == 0) ? 128 : (j == 1) ? 64 : 0; }
            else { g = pg8::Gemm{(const bf16*)(ws + W_V_B), xn, DM, MROWS, DM}; O = (bf16*)(ws + G_VT_B); }
            pg8::StaticOrder S; S.init(g.M, g.N, G, (bx + rot) % G); S.reps = phase_reps_raw(base + 0);
            pg8::EpiVT E{O, (const float*)(ws + (isA ? (j == 0 ? WS_RS0 : (j == 1 ? WS_RS1 : WS_RS2)) : WS_RS0))};
            pg8::gemm_phase<pg8::EpiVT, pg8::StaticOrder, true, true>(lds, g, S, E);
            __syncthreads();
        }
    PH_END(base + 0)
    PH_BEGIN(base + 1)
        if (isA) {
            for (int su = bx; su < 768; su += G) {
                const int grp = su >> 8, hu = 2 * (su & 255) + (tid >> 8);
                const int r = (grp == 0) ? 1 : (grp == 1) ? 4 : 16, Lq = SEQ / r, nqb = Lq / 128;
                const int j = hu & 3, qb = (hu >> 2) % nqb, sq = (hu >> 2) / nqb, b = sq / r, rho = sq % r, hd12 = grp * 4 + j;
                AttnHalf U;
                const size_t row0 = (size_t)b * SEQ + rho, sbase = (size_t)b * SEQ + (size_t)rho * Lq;
                U.Q = (const bf16*)(ws + G_QK_A) + ((size_t)hd12 * MROWS + sbase) * 64; U.K = (const bf16*)(ws + G_QK_A + 24 * MiB) + ((size_t)hd12 * MROWS + sbase) * 64; U.q_stride = 64; U.k_stride = 64;
                U.VT = (const bf16*)(ws + G_VT_A) + (size_t)grp * 256 * MROWS + ((size_t)j * 256 + (sbase >> 6)) * 4096; U.vt_pitch = 0;
                U.O = (bf16*)(ws + G_O_A) + row0 * AW + hd12 * 64; U.o_stride = r * AW;
                U.lse = (float*)(ws + WS_LSE) + row0 * 12 + hd12; U.lse_stride = r * 12; U.cq = nullptr;
                U.q0 = qb * 128; U.kv_begin = U.q0 - 128; U.nback = 128; U.pos0 = rho; U.pos_step = r;
                attn_super<1, false, false>(U, 4, lds, ropetab, tid);
            }
        } else {
            for (int i = 0; i < 4; ++i) {
                for (int w = bx; w < 256; w += G) {
                    const int pair = w >> 2, sx = w & 3, qb = (i == 0) ? sx : (i == 1) ? 15 - sx : (i == 2) ? 4 + sx : 11 - sx;
                    const int b = pair >> 3, hd = 2 * (pair & 7) + (tid >> 8);
                    AttnHalf U;
                    U.Q = (const bf16*)(ws + G_Q_B) + ((size_t)hd * MROWS + (size_t)b * SEQ) * 64; U.K = (const bf16*)(ws + G_K_B) + ((size_t)hd * MROWS + (size_t)b * SEQ) * 64; U.q_stride = 64; U.k_stride = 64;
                    U.VT = (const bf16*)(ws + G_VT_B) + ((size_t)hd * 256 + (size_t)b * (SEQ / 64)) * 4096; U.vt_pitch = 0;
                    U.O = (bf16*)(ws + G_O_B) + (size_t)b * SEQ * DM + hd * 64; U.o_stride = DM; U.lse = nullptr; U.lse_stride = 0;
                    U.cq = (const float*)(ws + WS_C2) + (size_t)(b * 16 + hd) * SEQ;
                    U.q0 = qb * 128; U.kv_begin = 0; U.nback = 1 << 30; U.pos0 = 0; U.pos_step = 0;
                    attn_super<1, false, true>(U, 2 * (qb + 1), lds, ropetab, tid);
                }
            }
        }
    PH_END(base + 1)
    if (isA) {
    PH_BEGIN(base + 2)
        const float* lse = (const float*)(ws + WS_LSE); bf16* o = (bf16*)(ws + G_O_A);
        for (int idx = bx * 512 + tid; idx < MROWS * 96; idx += G * 512) {
            const int m = idx / 96, hd12 = (idx >> 3) % 12, j = hd12 & 3, grp = hd12 >> 2;
            const float l0 = lse[(size_t)m * 12 + j], l1 = lse[(size_t)m * 12 + 4 + j], l2 = lse[(size_t)m * 12 + 8 + j];
            const float mx = fmaxf(l0, fmaxf(l1, l2));
            const float e0 = __builtin_amdgcn_exp2f(l0 - mx), e1 = __builtin_amdgcn_exp2f(l1 - mx), e2 = __builtin_amdgcn_exp2f(l2 - mx);
            const float wgt = ((grp == 0) ? e0 : (grp == 1) ? e1 : e2) / (e0 + e1 + e2);
            u32x4 v = *(const u32x4*)(o + (size_t)idx * 8);
#pragma unroll
            for (int e = 0; e < 4; ++e) v[e] = pk2(bf_lo(v[e]) * wgt, bf_hi(v[e]) * wgt);
            *(u32x4*)(o + (size_t)idx * 8) = v;
        }
    PH_END(base + 2)
    }
    PH_BEGIN(base + 3)
        pg8::Gemm g;
        if (isA) g = pg8::Gemm{(const bf16*)(ws + G_O_A), (const bf16*)(ws + W_O_A + l * 3 * MiB / 2), MROWS, DM, AW};
        else g = pg8::Gemm{(const bf16*)(ws + G_O_B), (const bf16*)(ws + W_O_B + (l - 2) * 2 * MiB), MROWS, DM, DM};
        pg8::StaticOrder S; S.init(g.M, g.N, G, bx); S.reps = phase_reps_raw(base + 3);
        pg8::EpiBf16<0> E{(bf16*)Fb, DM, nullptr, 0, 0, 1.f};
        pg8::gemm_phase<pg8::EpiBf16<0>, pg8::StaticOrder, true, true>(lds, g, S, E);
    PH_END(base + 3)
    PH_BEGIN(base + 4)
        row_phase<1>(Fb, gains + (l * 4 + 1) * DM, xn, nullptr, nullptr, nullptr, (float*)(ws + WS_RS0), nullptr, nullptr, false, false, (const LAS float*)lds, nullptr, nullptr, gw, NGW, lane);
    PH_END(base + 4)
    PH_BEGIN(base + 5)
        pg8::Gemm g{xn, (const bf16*)(ws + W_UP + l * 11 * MiB), MROWS, NUP, DM};
        pg8::StaticOrder S; S.init(g.M, g.N, G, bx); S.reps = phase_reps_raw(base + 5);
        pg8::EpiConvGlu E{(bf16*)(ws + G_U), Fb, a.in[IN_CONVW] + (size_t)l * 3 * NUP, a.in[IN_CONVB] + (size_t)l * NUP, (const float*)(ws + WS_RS0)};
        pg8::gemm_phase<pg8::EpiConvGlu, pg8::StaticOrder, true, true>(lds, g, S, E);
    PH_END(base + 5)
    PH_BEGIN(base + 7)
        pg8::Gemm g{(const bf16*)(ws + G_U), (const bf16*)(ws + W_DN + l * 11 * MiB / 2), MROWS, DM, DFF};
        pg8::StaticOrder S; S.init(g.M, g.N, G, bx); S.reps = phase_reps_raw(base + 7);
        {
            pg8::Unit u0;
            if (S.next(0, u0)) {
                const float* side = Fb; const float* cw = a.in[IN_CONVW] + (size_t)l * 3 * NUP; const float* cb = a.in[IN_CONVB] + (size_t)l * NUP; bf16* Ub = (bf16*)(ws + G_U);
                for (int idx = tid; idx < 4 * 2 * 704; idx += 512) {
                    const int cg4 = idx % 704, rr = (idx / 704) & 1, c = u0.pm * 4 + idx / 1408, ch = 4 * cg4; const bool first = (c % 32) == 0;
                    f32x4 o;
#pragma unroll
                    for (int hv = 0; hv < 2; ++hv) {
                        const int col = hv * DFF + ch; const f32x4 z = (f32x4){0.f, 0.f, 0.f, 0.f};
                        const f32x4 s0 = *(const f32x4*)(side + (size_t)(c * 4 + 0) * NUP + col);
                        const f32x4 p3 = first ? z : *(const f32x4*)(side + (size_t)(c * 4 - 1) * NUP + col);
                        f32x4 at, at1, at2;
                        if (rr == 0) { at = s0; at1 = p3; at2 = first ? z : *(const f32x4*)(side + (size_t)(c * 4 - 2) * NUP + col); }
                        else { at = *(const f32x4*)(side + (size_t)(c * 4 + 1) * NUP + col); at1 = s0; at2 = p3; }
                        const f32x4 r = *(const f32x4*)(cw + col) * at2 + *(const f32x4*)(cw + NUP + col) * at1 + *(const f32x4*)(cw + 2 * NUP + col) * at + *(const f32x4*)(cb + col);
                        if (hv == 0) { o.x = pg8::gelu_tanh(r.x); o.y = pg8::gelu_tanh(r.y); o.z = pg8::gelu_tanh(r.z); o.w = pg8::gelu_tanh(r.w); } else o = o * r;
                    }
                    u32x2 w; w.x = pk2(o.x, o.y); w.y = pk2(o.z, o.w);
                    *(u32x2*)(Ub + (size_t)(c * 64 + rr) * DFF + ch) = w;
                }
            }
            asm volatile("s_waitcnt vmcnt(0)" ::: "memory");
            __syncthreads();
        }
        pg8::EpiBf16<0> E{(bf16*)Fb, DM, nullptr, 0, 0, 1.f};
        pg8::gemm_phase<pg8::EpiBf16<0>, pg8::StaticOrder, true, true>(lds, g, S, E);
    PH_END(base + 7)
    PH_BEGIN(base + 8)
        constexpr bool last = (L == NLAYER - 1), forget = (L == 1);
        if (forget) { const float* wsrc = (const float*)(ws + WS_WFT); LAS float* wl = (LAS float*)lds;
            for (int i = tid; i < 16 * DM / 4; i += 512) *(LAS f32x4*)(wl + 4 * i) = *(const f32x4*)(wsrc + 4 * i);
            __syncthreads(); }
        row_phase<1>(Fb, gains + (l * 4 + 3) * DM, xn, last ? h : (float*)nullptr, (bf16*)(ws + G_XP1), (bf16*)(ws + G_XP2), (float*)(ws + WS_RS0), (float*)(ws + WS_RS1), (float*)(ws + WS_RS2), L == 0, forget, (const LAS float*)lds, a.in[IN_BF], (float*)(ws + WS_FLOG), gw, NGW, lane);
    PH_END(base + 8)
}

__global__ void __launch_bounds__(512, 2) yoco_fwd(Args a) {
    extern __shared__ __attribute__((aligned(16))) unsigned char lds_raw[];
    LAS unsigned char* lds = (LAS unsigned char*)lds_raw;
    cg::grid_group grid = cg::this_grid();
    if (threadIdx.x < 2) ((volatile LAS unsigned*)(lds + LDS_MISC))[threadIdx.x] = 0u;
    __syncthreads();
    PH_BEGIN(0)
        if (bx == 0) { unsigned* bw = (unsigned*)(ws + WS_BAR); for (int i = tid; i < XCD_BAR_WORDS; i += 512) bw[i] = 0u; }
        LAS float* scr = (LAS float*)(lds + wave * 16384);
        int off = 0;
        for (int l = 0; l < 2; ++l) {
            const float* g0 = gains + (l * 4 + 0) * DM; const float* W = a.in[IN_WQKV_A] + (size_t)l * DM * 2304;
            conv_mat(W, 2304, DM, 0, 768, (bf16*)(ws + W_QK_A + l * 3 * MiB), 0, g0, QSCALE, scr, gw, NGW, lane, off);
            conv_mat(W, 2304, DM, 768, 768, (bf16*)(ws + W_QK_A + l * 3 * MiB) + (size_t)768 * DM, 0, g0, 1.f, scr, gw, NGW, lane, off);
            conv_mat(W, 2304, DM, 1536, 768, (bf16*)(ws + W_V_A + l * 3 * MiB / 2), 0, g0, 1.f, scr, gw, NGW, lane, off);
            conv_mat(a.in[IN_WO_A] + (size_t)l * AW * DM, DM, AW, 0, DM, (bf16*)(ws + W_O_A + l * 3 * MiB / 2), 0, nullptr, 1.f, scr, gw, NGW, lane, off);
        }
        {
            const float* kvn = a.in[IN_KVNORM];
            conv_mat(a.in[IN_WQ_B], DM, DM, 0, DM, (bf16*)(ws + W_QK_B), 0, gains + (2 * 4 + 0) * DM, QSCALE, scr, gw, NGW, lane, off);
            conv_mat(a.in[IN_WKVF], 2064, DM, 0, DM, (bf16*)(ws + W_QK_B) + (size_t)DM * DM, 0, kvn, 1.f, scr, gw, NGW, lane, off);
            conv_mat(a.in[IN_WKVF], 2064, DM, DM, DM, (bf16*)(ws + W_V_B), 0, kvn, 1.f, scr, gw, NGW, lane, off);
            conv_mat(a.in[IN_WQ_B] + (size_t)DM * DM, DM, DM, 0, DM, (bf16*)(ws + W_Q_B1), 0, gains + (3 * 4 + 0) * DM, QSCALE, scr, gw, NGW, lane, off);
            for (int j = 0; j < 2; ++j) conv_mat(a.in[IN_WO_B] + (size_t)j * DM * DM, DM, DM, 0, DM, (bf16*)(ws + W_O_B + j * 2 * MiB), 0, nullptr, 1.f, scr, gw, NGW, lane, off);
        }
        for (int l = 0; l < NLAYER; ++l) {
            conv_mat(a.in[IN_WUP] + (size_t)l * DM * NUP, NUP, DM, 0, NUP, (bf16*)(ws + W_UP + l * 11 * MiB), 1, gains + (l * 4 + 2) * DM, 1.f, scr, gw, NGW, lane, off);
            conv_mat(a.in[IN_WDOWN] + (size_t)l * DFF * DM, DM, DFF, 0, DM, (bf16*)(ws + W_DN + l * 11 * MiB / 2), 0, nullptr, 1.f, scr, gw, NGW, lane, off);
        }
        const int gt = bx * 512 + tid;
        if (gt < SEQ * 8) { const int pos = gt >> 3, i = gt & 7; float sn, cs; sincos_f64((float)pos * a.invf[i], sn, cs);
            ((float*)(ws + WS_ROPE))[gt] = cs; ((float*)(ws + WS_ROPE))[SEQ * 8 + gt] = sn; }
        if (gt < 16 * DM) { const int hd = gt >> 10, k = gt & 1023; ((float*)(ws + WS_WFT))[gt] = a.in[IN_WKVF][(size_t)k * 2064 + 2048 + hd] * a.in[IN_KVNORM][k]; }
        row_phase<0>(a.in[IN_X], nullptr, xn, nullptr, (bf16*)(ws + G_XP1), (bf16*)(ws + G_XP2), (float*)(ws + WS_RS0), (float*)(ws + WS_RS1), (float*)(ws + WS_RS2), true, false, (const LAS float*)lds, nullptr, nullptr, gw, NGW, lane);
    PH_END(0)
    run_layer<0>(a, lds, grid);
    run_layer<1>(a, lds, grid);
    run_layer<2>(a, lds, grid);
    run_layer<3>(a, lds, grid);
}

#ifndef MK_SINGLE
#define MK_SINGLE 1
#endif
extern "C" void kernel_launch(void* const* d_in, const int* in_sizes, int n_in, void* d_out, int out_size, void* d_ws, size_t ws_size, hipStream_t stream) {
    static int grid = 0;
    if (grid == 0) {
        if (n_in != 13 || out_size != MROWS * DM || ws_size < WS_END) { fprintf(stderr, "kernel_launch: unexpected shapes (n_in %d, out %d, ws %zu)\n", n_in, out_size, ws_size); grid = -1; return; }
        int dev = 0, cus = 0, per_cu = 0;
        hipGetDevice(&dev); hipDeviceGetAttribute(&cus, hipDeviceAttributeMultiprocessorCount, dev);
        if (hipFuncSetAttribute((const void*)yoco_fwd, hipFuncAttributeMaxDynamicSharedMemorySize, LDS_BYTES) != hipSuccess) { fprintf(stderr, "kernel_launch: hipFuncSetAttribute failed\n"); grid = -1; return; }
        hipOccupancyMaxActiveBlocksPerMultiprocessor(&per_cu, (const void*)yoco_fwd, 512, LDS_BYTES);
        if (per_cu < 1) { fprintf(stderr, "kernel_launch: occupancy query says %d\n", per_cu); per_cu = 1; }
        (void)hipGetLastError();
        grid = cus * 1;
        fprintf(stderr, "kernel_launch: grid %d (per_cu %d)\n", grid, per_cu);
    }
    if (grid < 0) return;
    Args a{};
    for (int i = 0; i < 13; ++i) a.in[i] = (const float*)d_in[i];
    a.out = (float*)d_out; a.ws = (unsigned char*)d_ws;
    for (int i = 0; i < 8; ++i) a.invf[i] = powf(500000.0f, -(float)(2 * i) / 16.0f);
#if MK_SINGLE
    a.ph_lo = 0; a.ph_hi = NPHASE;
    void* args[] = {&a};
    hipError_t e = hipLaunchCooperativeKernel((const void*)yoco_fwd, dim3(grid), dim3(512), args, LDS_BYTES, stream);
    if (e != hipSuccess) fprintf(stderr, "cooperative launch failed: %s (grid %d)\n", hipGetErrorString(e), grid);
#else
    for (int ph = 0; ph < NPHASE; ++ph) {
        if (phase_noop(ph)) continue;
        a.ph_lo = ph; a.ph_hi = ph + 1;
        hipLaunchKernelGGL(yoco_fwd, dim3(grid), dim3(512), LDS_BYTES, stream, a);
    }
#endif
}
```

```cpp
#include <hip/hip_runtime.h>
#include <hip/hip_cooperative_groups.h>
#include <cstdio>
#include <cstdint>
#include <cmath>
namespace cg = cooperative_groups;
namespace pg8 {
#define PG8_LAS __attribute__((address_space(3)))
typedef unsigned short bf16_t;
typedef short bf16x8 __attribute__((ext_vector_type(8)));
typedef float f32x4 __attribute__((ext_vector_type(4)));
typedef unsigned u32x4 __attribute__((ext_vector_type(4)));
constexpr int BM = 256, BK = 64, HALF = 128, HTB = HALF * BK * 2  , STAGE_BYTES = 8 * HTB, NXCD = 8, WGM = 8;

__host__ __device__ __forceinline__ int lds_byte(int r, int c) { const int st = (r >> 4) * 2 + (c >> 5), rr = r & 15, cc = c & 31, ob = rr * 64 + cc * 2; return st * 1024 + (ob ^ (((ob >> 9) & 1) << 5)); }
__host__ __device__ __forceinline__ void stage_rc(int b, int& R, int& C) { const int st = b / 1024, sb = b % 1024, swz = sb ^ (((sb >> 9) & 1) << 5); R = (st >> 1) * 16 + swz / 64; C = (st & 1) * 32 + (swz % 64) / 2; }
__host__ __device__ __forceinline__ int perm32(int rho) { const int n = rho >> 4, i = rho & 15; return 8 * (i >> 2) + 4 * n + (i & 3); }

struct Unit { int pm, pn; };
struct Gemm { const bf16_t* A; const bf16_t* Bt; int M, N, K; };

struct StaticOrder {
    int nM, nN, nwg, G, c, reps;
    __host__ __device__ void init(int M, int N, int G_, int c_) { nM = M / BM; nN = N / BM; nwg = nM * nN; G = G_; c = c_; reps = 1; }
    __host__ __device__ bool next(int i, Unit& u) const {
        if (reps > 1) { const int nmine = (c < nwg) ? (nwg - c + G - 1) / G : 0; if (i >= reps * nmine) return false; i = i % nmine; }
        const long L = (long)i * G + c; if (L >= nwg) return false;
        int wgid = (int)L; { const int q = nwg / NXCD, r = nwg % NXCD, xcd = wgid % NXCD, off = wgid / NXCD; wgid = (xcd < r ? xcd * (q + 1) : r * (q + 1) + (xcd - r) * q) + off; }
        const int nig = WGM * nN, gid = wgid / nig, fm = gid * WGM, gsz = (nM - fm) < WGM ? (nM - fm) : WGM;
        u.pm = fm + ((wgid % nig) % gsz); u.pn = (wgid % nig) / gsz; return true;
    }
    __device__ __forceinline__ void a_ready(const Unit&) const {}
    __device__ __forceinline__ void done(const Unit&) const {}
};

__device__ __forceinline__ unsigned cvt_pk_bf16(float lo, float hi) { unsigned r; asm volatile("v_cvt_pk_bf16_f32 %0, %1, %2" : "=v"(r) : "v"(lo), "v"(hi)); return r; }
typedef float f32x2 __attribute__((ext_vector_type(2)));
__device__ __forceinline__ f32x2 gelu_pk(f32x2 v) {
    const f32x2 av = __builtin_elementwise_abs(v), d = av * 0.2316418882f + 1.0f;
    f32x2 t; t.x = __builtin_amdgcn_rcpf(d.x); t.y = __builtin_amdgcn_rcpf(d.y);
    f32x2 q = t * 0.5307027145f + (-0.7265760135f); q = q * t + 0.7107068705f; q = q * t + (-0.142248368f); q = q * t + 0.127414796f; q = q * t;
    const f32x2 s = (v * v) * (-0.72134752044f);
    f32x2 e; e.x = __builtin_amdgcn_exp2f(s.x); e.y = __builtin_amdgcn_exp2f(s.y);
    const f32x2 m = v * (q * e), r = v - m;
    f32x2 o; o.x = v.x < 0.f ? m.x : r.x; o.y = v.y < 0.f ? m.y : r.y; return o;
}

template <int ACT  > struct EpiBf16 {
    static constexpr bool PERM = true, AFTER_DRAIN = false; static_assert(ACT == 0 || ACT == 1, "EpiBf16: ACT is 0 (none) or 1 (gelu_pk)");
    bf16_t* O; int ldc; const float* bias; int split_cols; size_t split_stride; float scale0;
    __device__ __forceinline__ void operator()(const f32x4 (&acc)[2][2][4][2], const Unit& u, int wr, int wc, int fr, int fq) const {
        const int row0 = u.pm * BM + wr * 64 + fr; int colt = u.pn * BM; bf16_t* base = O;
        float sc = 1.f; if (split_cols) { const int t = colt / split_cols; base += (size_t)t * split_stride; colt -= t * split_cols; if (t == 0) sc = scale0; }
        const int col0 = colt + wc * 32 + 8 * fq, bcol0 = u.pn * BM + wc * 32 + 8 * fq;
        f32x4 bv[2][2];
#pragma unroll
        for (int bj = 0; bj < 2; ++bj)
#pragma unroll
            for (int n = 0; n < 2; ++n) bv[bj][n] = bias ? *(const f32x4*)(bias + bcol0 + bj * HALF + 4 * n) : (f32x4){0.f, 0.f, 0.f, 0.f};
#pragma unroll
        for (int ai = 0; ai < 2; ++ai)
#pragma unroll
            for (int m = 0; m < 4; ++m) { bf16_t* rowp = base + (size_t)(row0 + ai * HALF + m * 16) * ldc + col0;
#pragma unroll
                for (int bj = 0; bj < 2; ++bj) { f32x4 v0 = acc[ai][bj][m][0] + bv[bj][0], v1 = acc[ai][bj][m][1] + bv[bj][1];
                    if (ACT == 1) { f32x2 a = gelu_pk((f32x2){v0[0], v0[1]}), b = gelu_pk((f32x2){v0[2], v0[3]}), c = gelu_pk((f32x2){v1[0], v1[1]}), d = gelu_pk((f32x2){v1[2], v1[3]});
                        v0 = (f32x4){a.x, a.y, b.x, b.y}; v1 = (f32x4){c.x, c.y, d.x, d.y}; }
                    v0 = v0 * sc; v1 = v1 * sc; u32x4 w; w.x = cvt_pk_bf16(v0[0], v0[1]); w.y = cvt_pk_bf16(v0[2], v0[3]); w.z = cvt_pk_bf16(v1[0], v1[1]); w.w = cvt_pk_bf16(v1[2], v1[3]);
                    *(u32x4*)(rowp + bj * HALF) = w; } }
    }
};
template <class Epi, class Sched, bool ALIGN_EPI = false, bool SP2 = false>
__device__ __forceinline__ void gemm_phase(PG8_LAS unsigned char* lds, const Gemm g, const Sched& S, const Epi& E) {
    const int tid = threadIdx.x, wid = __builtin_amdgcn_readfirstlane(tid >> 6), lane = tid & 63, wr = wid >> 2, wc = wid & 3, fr = lane & 15, fq = lane >> 4;
    const int K = g.K, nt = K / BK;
    unsigned voffA[2], voffB[2];
#pragma unroll
    for (int i = 0; i < 2; ++i) { int R, C; stage_rc(tid * 16 + i * 8192, R, C); const int Rb = Epi::PERM ? ((R & ~31) + perm32(R & 31)) : R;
        voffA[i] = (unsigned)(R * K + C) * 2u; voffB[i] = (unsigned)(Rb * K + C) * 2u; }
    const size_t kstep = (size_t)(BK * 2);
    const size_t hstep = (size_t)HALF * K * 2;
    const size_t tstep = 2 * hstep;
    const unsigned ldsw = (unsigned)wid * 1024u;
    const int aoff = lds_byte(wr * 64 + fr, fq * 8), boff = lds_byte(wc * 32 + fr, fq * 8);
#define PG8_SA(b, h) (((b) * 2 + (h)) * HTB)
#define PG8_SB(b, h) ((4 + (b) * 2 + (h)) * HTB)
#define PG8_STAGE(bufoff, gbase, voff) do { _Pragma("unroll") for (int _i = 0; _i < 2; ++_i) \
        __builtin_amdgcn_global_load_lds((const unsigned*)((const char*)(gbase) + (voff)[_i]), (PG8_LAS unsigned*)(lds + (bufoff) + ldsw + _i * 8192), 16, 0, 0); } while (0)
#define PG8_LDA(dst, b, h) do { _Pragma("unroll") for (int m = 0; m < 4; ++m) _Pragma("unroll") for (int k = 0; k < 2; ++k) dst[m][k] = *(const PG8_LAS bf16x8*)(lds + PG8_SA(b, h) + aoff + m * 2048 + k * 1024); } while (0)
#define PG8_LDB(dst, b, h) do { _Pragma("unroll") for (int n = 0; n < 2; ++n) _Pragma("unroll") for (int k = 0; k < 2; ++k) dst[n][k] = *(const PG8_LAS bf16x8*)(lds + PG8_SB(b, h) + boff + n * 2048 + k * 1024); } while (0)
#define PG8_MMA(ai, bj, At, Bt) do { __builtin_amdgcn_s_setprio(1); _Pragma("unroll") for (int m = 0; m < 4; ++m) _Pragma("unroll") for (int n = 0; n < 2; ++n) _Pragma("unroll") for (int k = 0; k < 2; ++k) \
        acc[ai][bj][m][n] = __builtin_amdgcn_mfma_f32_16x16x32_bf16(Bt[n][k], At[m][k], acc[ai][bj][m][n], 0, 0, 0); __builtin_amdgcn_s_setprio(0); } while (0)
#define PG8_WAIT_V(n) asm volatile("s_waitcnt vmcnt(" #n ")" ::: "memory")
#define PG8_WAIT_L(n) asm volatile("s_waitcnt lgkmcnt(" #n ")" ::: "memory")
#define PG8_BAR __builtin_amdgcn_s_barrier()
#define PG8_SCHED __builtin_amdgcn_sched_barrier(0)
    Unit cur, nxt; int ui = 0;
    if (!S.next(0, cur)) return;
    f32x4 acc[2][2][4][2];
#pragma unroll
    for (int a = 0; a < 2; ++a)
#pragma unroll
        for (int b = 0; b < 2; ++b)
#pragma unroll
            for (int m = 0; m < 4; ++m)
#pragma unroll
                for (int n = 0; n < 2; ++n) acc[a][b][m][n] = (f32x4){0.f, 0.f, 0.f, 0.f};
    bf16x8 At[4][2], B0[2][2], B1[2][2];
    const char* cA = (const char*)g.A + (size_t)cur.pm * tstep; const char* cB = (const char*)g.Bt + (size_t)cur.pn * tstep;
    S.a_ready(cur);
    if constexpr (SP2) {
        PG8_STAGE(PG8_SB(0, 0), cB, voffB); PG8_STAGE(PG8_SB(0, 1), cB + hstep, voffB); PG8_STAGE(PG8_SA(0, 0), cA, voffA); PG8_STAGE(PG8_SA(0, 1), cA + hstep, voffA);
        if (wr == 1) PG8_BAR;
        PG8_WAIT_V(2); PG8_BAR;
        PG8_STAGE(PG8_SB(1, 0), cB + kstep, voffB); PG8_STAGE(PG8_SA(1, 0), cA + kstep, voffA); PG8_STAGE(PG8_SB(1, 1), cB + hstep + kstep, voffB);
        PG8_WAIT_V(6); PG8_BAR;
    } else {
        PG8_STAGE(PG8_SB(0, 0), cB, voffB); PG8_STAGE(PG8_SA(0, 0), cA, voffA); PG8_STAGE(PG8_SB(0, 1), cB + hstep, voffB); PG8_STAGE(PG8_SA(0, 1), cA + hstep, voffA);
        if (wr == 1) PG8_BAR;
        PG8_WAIT_V(4); PG8_BAR;
        PG8_STAGE(PG8_SB(1, 0), cB + kstep, voffB); PG8_STAGE(PG8_SA(1, 0), cA + kstep, voffA); PG8_STAGE(PG8_SB(1, 1), cB + hstep + kstep, voffB);
        PG8_WAIT_V(6); PG8_BAR;
    }
    for (;;) {
        const bool has_next = S.next(ui + 1, nxt);
        const char* nA = has_next ? (const char*)g.A + (size_t)nxt.pm * tstep : cA; const char* nB = has_next ? (const char*)g.Bt + (size_t)nxt.pn * tstep : cB;
        for (int t = 0; t < nt; t += 2) {
            const bool last = (t == nt - 2);
            const char* a1 = cA + (size_t)(t + 1) * kstep;
            const char* a2 = last ? nA : cA + (size_t)(t + 2) * kstep; const char* b2 = last ? nB : cB + (size_t)(t + 2) * kstep;
            const char* a3 = a2 + kstep; const char* b3 = b2 + kstep;
            if (last && has_next) S.a_ready(nxt);
            if constexpr (SP2) {
            PG8_LDB(B0, 0, 0); PG8_LDB(B1, 0, 1); PG8_SCHED; PG8_LDA(At, 0, 0); PG8_STAGE(PG8_SA(1, 1), a1 + hstep, voffA);
            PG8_WAIT_V(8); PG8_WAIT_L(0); PG8_BAR; PG8_MMA(0, 0, At, B0); PG8_MMA(0, 1, At, B1); PG8_BAR; PG8_SCHED;
            PG8_LDA(At, 0, 1); PG8_STAGE(PG8_SB(0, 0), b2, voffB); PG8_STAGE(PG8_SB(0, 1), b2 + hstep, voffB); PG8_STAGE(PG8_SA(0, 0), a2, voffA);
            PG8_WAIT_V(8); PG8_WAIT_L(0); PG8_BAR; PG8_MMA(1, 0, At, B0); PG8_MMA(1, 1, At, B1); PG8_BAR; PG8_SCHED;
            PG8_LDB(B0, 1, 0); PG8_LDB(B1, 1, 1); PG8_SCHED; PG8_LDA(At, 1, 0); PG8_STAGE(PG8_SA(0, 1), a2 + hstep, voffA);
            PG8_WAIT_V(8); PG8_WAIT_L(0); PG8_BAR; PG8_MMA(0, 0, At, B0); PG8_MMA(0, 1, At, B1); PG8_BAR; PG8_SCHED;
            PG8_LDA(At, 1, 1); PG8_STAGE(PG8_SB(1, 0), b3, voffB); PG8_STAGE(PG8_SB(1, 1), b3 + hstep, voffB); PG8_STAGE(PG8_SA(1, 0), a3, voffA);
            PG8_WAIT_V(8); PG8_WAIT_L(0); PG8_BAR; PG8_MMA(1, 0, At, B0); PG8_MMA(1, 1, At, B1); PG8_BAR; PG8_SCHED;
            } else {
            PG8_LDB(B0, 0, 0); PG8_SCHED; PG8_LDA(At, 0, 0); PG8_STAGE(PG8_SA(1, 1), a1 + hstep, voffA);
            PG8_WAIT_L(8); PG8_BAR; PG8_WAIT_L(0); PG8_MMA(0, 0, At, B0); PG8_BAR; PG8_SCHED;
            PG8_LDB(B1, 0, 1); PG8_STAGE(PG8_SB(0, 0), b2, voffB);
            PG8_BAR; PG8_WAIT_L(0); PG8_MMA(0, 1, At, B1); PG8_BAR;
            PG8_LDA(At, 0, 1); PG8_STAGE(PG8_SA(0, 0), a2, voffA);
            PG8_BAR; PG8_WAIT_L(0); PG8_MMA(1, 0, At, B0); PG8_BAR; PG8_SCHED;
            PG8_STAGE(PG8_SB(0, 1), b2 + hstep, voffB);
            PG8_WAIT_V(6); PG8_BAR; PG8_MMA(1, 1, At, B1); PG8_BAR;
            PG8_LDB(B0, 1, 0); PG8_SCHED; PG8_LDA(At, 1, 0); PG8_STAGE(PG8_SA(0, 1), a2 + hstep, voffA);
            PG8_WAIT_L(8); PG8_BAR; PG8_WAIT_L(0); PG8_MMA(0, 0, At, B0); PG8_BAR; PG8_SCHED;
            PG8_LDB(B1, 1, 1); PG8_STAGE(PG8_SB(1, 0), b3, voffB);
            PG8_BAR; PG8_WAIT_L(0); PG8_MMA(0, 1, At, B1); PG8_BAR;
            PG8_LDA(At, 1, 1); PG8_STAGE(PG8_SA(1, 0), a3, voffA);
            PG8_BAR; PG8_WAIT_L(0); PG8_MMA(1, 0, At, B0); PG8_BAR; PG8_SCHED;
            PG8_STAGE(PG8_SB(1, 1), b3 + hstep, voffB);
            PG8_WAIT_V(6); PG8_BAR; PG8_MMA(1, 1, At, B1); PG8_BAR;
            }
        }
        if constexpr (ALIGN_EPI) { if (wr == 0) PG8_BAR; }
        if constexpr (!Epi::AFTER_DRAIN) { E(acc, cur, wr, wc, fr, fq); S.done(cur); }
        if (!has_next) break;
#pragma unroll
        for (int a = 0; a < 2; ++a)
#pragma unroll
            for (int b = 0; b < 2; ++b)
#pragma unroll
                for (int m = 0; m < 4; ++m)
#pragma unroll
                    for (int n = 0; n < 2; ++n) acc[a][b][m][n] = (f32x4){0.f, 0.f, 0.f, 0.f};
        cur = nxt; cA = nA; cB = nB; ++ui;
        if constexpr (ALIGN_EPI) { if (wr == 1) PG8_BAR; }
    }
    PG8_WAIT_V(0);
    if constexpr (!ALIGN_EPI) { if (wr == 0) PG8_BAR; }
    PG8_BAR;
    if constexpr (Epi::AFTER_DRAIN) { E.fused(acc, cur, wr, wc, fr, fq, lds, wid, lane); S.done(cur); }
#undef PG8_SA
#undef PG8_SB
#undef PG8_STAGE
#undef PG8_LDA
#undef PG8_LDB
#undef PG8_MMA
#undef PG8_WAIT_V
#undef PG8_WAIT_L
#undef PG8_BAR
#undef PG8_SCHED
}
}

#define LAS __attribute__((address_space(3)))
typedef unsigned short bf16;
typedef short bf16x8 __attribute__((ext_vector_type(8)));
typedef short s16x4 __attribute__((ext_vector_type(4)));
typedef float f32x4 __attribute__((ext_vector_type(4)));
typedef float f32x16 __attribute__((ext_vector_type(16)));
typedef unsigned u32x4 __attribute__((ext_vector_type(4)));
typedef unsigned u32x2 __attribute__((ext_vector_type(2)));

constexpr int BATCH = 8, SEQ = 2048, DM = 1024, MROWS = BATCH * SEQ;
constexpr int AW = 768, DFF = 2816, NUP = 2 * DFF, NLAYER = 4;
constexpr float RMS_EPS = 1e-6f;
constexpr float LOG2E = 1.4426950408889634f;
constexpr float QSCALE = 0.125f * 1.4426950408889634f;
constexpr size_t MiB = 1u << 20;
constexpr size_t WS_ROPE = 64 * 1024;
constexpr size_t WS_WFT = 256 * 1024;
constexpr size_t WS_RS0 = 384 * 1024, WS_RS1 = 448 * 1024, WS_RS2 = 512 * 1024;
constexpr size_t WS_W = 1 * MiB;
constexpr size_t W_QK_A = WS_W, W_V_A = WS_W + 6 * MiB, W_O_A = WS_W + 9 * MiB, W_QK_B = WS_W + 12 * MiB, W_V_B = WS_W + 16 * MiB,
                 W_Q_B1 = WS_W + 18 * MiB, W_O_B = WS_W + 20 * MiB, W_UP = WS_W + 24 * MiB, W_DN = WS_W + 68 * MiB;
constexpr size_t WS_C2 = 91 * MiB, WS_FLOG = 92 * MiB, WS_LSE = 93 * MiB;
constexpr size_t WS_XN = 94 * MiB;
constexpr size_t WS_F = 126 * MiB;
constexpr size_t WS_G = 190 * MiB;
constexpr size_t G_QK_A = WS_G, G_VT_A = WS_G + 48 * MiB, G_O_A = WS_G + 72 * MiB, G_XP1 = WS_G + 96 * MiB, G_XP2 = WS_G + 128 * MiB;
constexpr size_t G_Q_B = WS_G, G_O_B = WS_G + 32 * MiB, G_K_B = WS_G + 96 * MiB, G_VT_B = WS_G + 128 * MiB;
constexpr size_t G_U = WS_G;
constexpr size_t WS_END = 352 * MiB;
constexpr int LDS_BYTES = 147456;
constexpr int LDS_MISC = 131072 + 320;
constexpr size_t WS_BAR = 16384;
constexpr int NPHASE = 1 + 9 * NLAYER;

__device__ __forceinline__ unsigned pk2(float lo, float hi) {
    typedef float f2 __attribute__((ext_vector_type(2))); typedef __bf16 b2 __attribute__((ext_vector_type(2)));
    f2 v = {lo, hi}; b2 b = __builtin_convertvector(v, b2); return __builtin_bit_cast(unsigned, b);
}
__device__ __forceinline__ float bf_lo(unsigned w) { return __uint_as_float(w << 16); }
__device__ __forceinline__ float bf_hi(unsigned w) { return __uint_as_float(w & 0xffff0000u); }
__device__ __forceinline__ float wave_sum(float v) {
#pragma unroll
    for (int o = 1; o < 64; o <<= 1) v += __shfl_xor(v, o);
    return v;
}
#define LDS_WAIT() asm volatile("s_waitcnt lgkmcnt(0)" ::: "memory")

namespace pg8 {
struct EpiF32 {
    static constexpr bool PERM = false, AFTER_DRAIN = false;
    float* O; int ldc;
    __device__ __forceinline__ void operator()(const f32x4 (&acc)[2][2][4][2], const Unit& u, int wr, int wc, int fr, int fq) const {
        const int row0 = u.pm * BM + wr * 64 + fr, col0 = u.pn * BM + wc * 32 + 4 * fq;
#pragma unroll
        for (int ai = 0; ai < 2; ++ai)
#pragma unroll
            for (int m = 0; m < 4; ++m) { float* rowp = O + (size_t)(row0 + ai * HALF + m * 16) * ldc + col0;
#pragma unroll
                for (int bj = 0; bj < 2; ++bj)
#pragma unroll
                    for (int n = 0; n < 2; ++n) *(f32x4*)(rowp + bj * HALF + n * 16) = acc[ai][bj][m][n]; }
    }
};
template <int CTRL> __device__ __forceinline__ float dppf(float old, float src) {
    return __int_as_float(__builtin_amdgcn_update_dpp(__float_as_int(old), __float_as_int(src), CTRL, 0xf, 0xf, false));
}
__device__ __forceinline__ float gelu_tanh(float x) {
    const float z = 0.7978845608028654f * (x + 0.044715f * x * x * x);
    const float e = __builtin_amdgcn_exp2f(-2.0f * 1.4426950408889634f * z);
    return x * __builtin_amdgcn_rcpf(1.0f + e);
}
struct EpiConvGlu {
    static constexpr bool PERM = true, AFTER_DRAIN = false;
    bf16_t* U; float* side; const float* cw; const float* cb; const float* rs;
    __device__ __forceinline__ void operator()(const f32x4 (&acc)[2][2][4][2], const Unit& u, int wr, int wc, int fr, int fq) const {
        const int chb = u.pn * HALF + wc * 32 + 8 * fq;
#pragma unroll
        for (int n = 0; n < 2; ++n) {
            const int ch = chb + 4 * n;
            const f32x4 wg0 = *(const f32x4*)(cw + ch), wg1 = *(const f32x4*)(cw + NUP + ch), wg2 = *(const f32x4*)(cw + 2 * NUP + ch), bg = *(const f32x4*)(cb + ch);
            const f32x4 wv0 = *(const f32x4*)(cw + DFF + ch), wv1 = *(const f32x4*)(cw + NUP + DFF + ch), wv2 = *(const f32x4*)(cw + 2 * NUP + DFF + ch), bv = *(const f32x4*)(cb + DFF + ch);
#pragma unroll
            for (int ai = 0; ai < 2; ++ai) {
                const int chunk = u.pm * 4 + ai * 2 + wr, rowbase = u.pm * BM + ai * HALF + wr * 64;
                float rr[4];
#pragma unroll
                for (int m = 0; m < 4; ++m) rr[m] = rs[rowbase + m * 16 + fr];
#pragma unroll
                for (int m = 0; m < 4; ++m) {
                    const f32x4 xg = acc[ai][0][m][n] * rr[m], xv = acc[ai][1][m][n] * rr[m];
                    if (m == 0 && fr < 2) { float* sp = side + (size_t)(chunk * 4 + fr) * NUP + ch; *(f32x4*)sp = xg; *(f32x4*)(sp + DFF) = xv; }
                    if (m == 3 && fr >= 14) { float* sp = side + (size_t)(chunk * 4 + fr - 12) * NUP + ch; *(f32x4*)sp = xg; *(f32x4*)(sp + DFF) = xv; }
                    f32x4 pg = (f32x4){0.f, 0.f, 0.f, 0.f}, pv = pg;
                    if (m > 0) { pg = acc[ai][0][m - 1][n] * rr[m - 1]; pv = acc[ai][1][m - 1][n] * rr[m - 1]; }
                    f32x4 g1, g2, v1, v2;
#pragma unroll
                    for (int e = 0; e < 4; ++e) {
                        g1[e] = dppf<0x111>(dppf<0x121>(0.f, pg[e]), xg[e]); g2[e] = dppf<0x112>(dppf<0x122>(0.f, pg[e]), xg[e]);
                        v1[e] = dppf<0x111>(dppf<0x121>(0.f, pv[e]), xv[e]); v2[e] = dppf<0x112>(dppf<0x122>(0.f, pv[e]), xv[e]);
                    }
                    const f32x4 cg = wg0 * g2 + wg1 * g1 + wg2 * xg + bg, cv = wv0 * v2 + wv1 * v1 + wv2 * xv + bv;
                    f32x4 o;
#pragma unroll
                    for (int e = 0; e < 4; ++e) o[e] = gelu_tanh(cg[e]) * cv[e];
                    if (!(m == 0 && fr < 2)) { u32x2 w; w.x = pk2(o[0], o[1]); w.y = pk2(o[2], o[3]); *(u32x2*)(U + (size_t)(rowbase + m * 16 + fr) * DFF + ch) = w; }
                }
            }
        }
    }
};
template <bool MODE_A> struct EpiHeads {
    static constexpr bool PERM = true, AFTER_DRAIN = false;
    bf16_t* Qo; bf16_t* Ko; int nhq; const float* rope; const float* rs;
    __device__ __forceinline__ void operator()(const f32x4 (&acc)[2][2][4][2], const Unit& u, int wr, int wc, int fr, int fq) const {
#pragma unroll
        for (int bj = 0; bj < 2; ++bj) {
            const int c = u.pn * BM + bj * HALF + wc * 32 + 8 * fq, hq = c >> 6, d = c & 63;
            const bool isK = hq >= nhq; const int head = isK ? hq - nhq : hq;
            bf16_t* base = (isK ? Ko : Qo) + (size_t)head * (MROWS * 64) + d;
            const int sh = MODE_A ? 2 * (head >> 2) : 0;
#pragma unroll
            for (int ai = 0; ai < 2; ++ai)
#pragma unroll
                for (int m = 0; m < 4; ++m) {
                    const int row = u.pm * BM + ai * HALF + wr * 64 + m * 16 + fr, t = row & (SEQ - 1);
                    const int prow = MODE_A ? ((row & ~(SEQ - 1)) + ((t & ((1 << sh) - 1)) << (11 - sh)) + (t >> sh)) : row;
                    const float rsr = rs[row];
                    f32x4 v0 = acc[ai][bj][m][0] * rsr, v1 = acc[ai][bj][m][1] * rsr;
                    if (MODE_A && (wc & 1) == 0) {
                        const float* ct = rope + t * 8;
                        const f32x4 c0 = *(const f32x4*)ct, c1 = *(const f32x4*)(ct + 4), s0 = *(const f32x4*)(ct + SEQ * 8), s1 = *(const f32x4*)(ct + SEQ * 8 + 4);
                        f32x4 p0, p1;
#pragma unroll
                        for (int e = 0; e < 4; ++e) { p0[e] = __shfl_xor(v0[e], 16); p1[e] = __shfl_xor(v1[e], 16); }
                        if (fq == 0) { v0 = v0 * c0 - p0 * s0; v1 = v1 * c1 - p1 * s1; }
                        else if (fq == 1) { v0 = v0 * c0 + p0 * s0; v1 = v1 * c1 + p1 * s1; }
                    }
                    u32x4 w; w.x = pk2(v0[0], v0[1]); w.y = pk2(v0[2], v0[3]); w.z = pk2(v1[0], v1[1]); w.w = pk2(v1[2], v1[3]);
                    *(u32x4*)(base + (size_t)prow * 64) = w;
                }
        }
    }
};
struct EpiVT {
    static constexpr bool PERM = true, AFTER_DRAIN = false;
    bf16_t* O; const float* rsc;
    __device__ __forceinline__ void operator()(const f32x4 (&acc)[2][2][4][2], const Unit& u, int wr, int wc, int fr, int fq) const {
        f32x4 rc[2][2];
#pragma unroll
        for (int bj = 0; bj < 2; ++bj) { const int col = u.pn * BM + bj * HALF + wc * 32 + 8 * fq; rc[bj][0] = *(const f32x4*)(rsc + col); rc[bj][1] = *(const f32x4*)(rsc + col + 4); }
#pragma unroll
        for (int ai = 0; ai < 2; ++ai)
#pragma unroll
            for (int m = 0; m < 4; ++m) { const int row = u.pm * BM + ai * HALF + wr * 64 + m * 16 + fr;
#pragma unroll
                for (int bj = 0; bj < 2; ++bj) { const int col = u.pn * BM + bj * HALF + wc * 32 + 8 * fq;
                    const f32x4 v0 = acc[ai][bj][m][0] * rc[bj][0], v1 = acc[ai][bj][m][1] * rc[bj][1];
                    u32x4 w; w.x = pk2(v0[0], v0[1]); w.y = pk2(v0[2], v0[3]); w.z = pk2(v1[0], v1[1]); w.w = pk2(v1[2], v1[3]);
                    *(u32x4*)(O + ((size_t)(((row >> 6) * 256 + (col >> 6)) * 64 + (row & 63))) * 64 + (col & 63)) = w; } }
    }
};
}

__device__ __forceinline__ void wt_item(const float* W, int ldw, int K, int k0, int ncol0, bf16* WT, int out_row0, const float* gain, float scale, LAS float* scr, int lane) {
    float wv[32];
#pragma unroll
    for (int i = 0; i < 32; ++i) wv[i] = W[(size_t)(k0 + 2 * i + (lane >> 5)) * ldw + ncol0 + (lane & 31)];
#pragma unroll
    for (int i = 0; i < 32; ++i) { const int kk = 2 * i + (lane >> 5); const float g = gain ? gain[k0 + kk] * scale : scale;
        scr[kk * 33 + (lane & 31)] = wv[i] * g; }
    LDS_WAIT();
    const int c = lane & 7;
#pragma unroll
    for (int j = 0; j < 4; ++j) { const int n = (lane >> 3) + 8 * j; const LAS float* s = scr + (8 * c) * 33 + n;
        u32x4 o; o.x = pk2(s[0 * 33], s[1 * 33]); o.y = pk2(s[2 * 33], s[3 * 33]); o.z = pk2(s[4 * 33], s[5 * 33]); o.w = pk2(s[6 * 33], s[7 * 33]);
        *(u32x4*)(WT + (size_t)(out_row0 + n) * K + k0 + 8 * c) = o; }
    LDS_WAIT();
}
__device__ __forceinline__ void conv_mat(const float* W, int ldw, int K, int col0, int ncols, bf16* WT, int mode, const float* gain, float scale,
                                         LAS float* scr, int gw, int NGW, int lane, int& off) {
    const int nnb = ncols / 32, nitems = (K / 64) * nnb;
    for (int it = (gw + NGW - off) % NGW; it < nitems; it += NGW) {
        const int kb = it / nnb, nb = it % nnb, n0 = 32 * nb;
        int out_row0 = n0;
        if (mode == 1) { const int bj = n0 / DFF, ch0 = n0 % DFF; out_row0 = 256 * (ch0 / 128) + 128 * bj + (ch0 % 128); }
        wt_item(W, ldw, K, 64 * kb, col0 + n0, WT, out_row0, gain, scale, scr, lane);
    }
    off = (off + nitems) % NGW;
}

__device__ __forceinline__ void sincos_f64(float ang, float& sn, float& cs) {
    const double x = (double)ang; const double k = __builtin_rint(x * 0.63661977236758134308);
    double r = __builtin_fma(-k, 1.57079632679489655800, x); r = __builtin_fma(-k, 6.12323399573676603587e-17, r);
    const double r2 = r * r;
    double s = 1.6059043836821613e-10; s = s * r2 - 2.5052108385441720e-08; s = s * r2 + 2.7557319223985893e-06; s = s * r2 - 1.9841269841269841e-04;
    s = s * r2 + 8.3333333333333332e-03; s = s * r2 - 1.6666666666666666e-01; s = s * r2 * r + r;
    double c = -1.1470745597729725e-11; c = c * r2 + 2.0876756987868100e-09; c = c * r2 - 2.7557319223985888e-07; c = c * r2 + 2.4801587301587302e-05;
    c = c * r2 - 1.3888888888888889e-03; c = c * r2 + 4.1666666666666664e-02; c = c * r2 - 0.5; c = c * r2 + 1.0;
    const int q = ((int)k) & 3;
    const double ss = (q == 0) ? s : (q == 1) ? c : (q == 2) ? -s : -c;
    const double cc = (q == 0) ? c : (q == 1) ? -s : (q == 2) ? -c : s;
    sn = (float)ss; cs = (float)cc;
}

enum { IN_X = 0, IN_GAINS, IN_WQKV_A, IN_WO_A, IN_WQ_B, IN_WO_B, IN_KVNORM, IN_WKVF, IN_BF, IN_WUP, IN_CONVW, IN_CONVB, IN_WDOWN };
template <int L>
__device__ __forceinline__ void convert_layer(const float* const* in, unsigned char* ws, LAS float* scr, int cw, int ncw, int lane) {
    const float* gains = in[IN_GAINS]; int off = 0; constexpr int l = L;
    if (L < 2) {
        const float* g0 = gains + (l * 4 + 0) * DM; const float* W = in[IN_WQKV_A] + (size_t)l * DM * 2304;
        conv_mat(W, 2304, DM, 0, 768, (bf16*)(ws + W_QK_A + l * 3 * MiB), 0, g0, QSCALE, scr, cw, ncw, lane, off);
        conv_mat(W, 2304, DM, 768, 768, (bf16*)(ws + W_QK_A + l * 3 * MiB) + (size_t)768 * DM, 0, g0, 1.f, scr, cw, ncw, lane, off);
        conv_mat(W, 2304, DM, 1536, 768, (bf16*)(ws + W_V_A + l * 3 * MiB / 2), 0, g0, 1.f, scr, cw, ncw, lane, off);
        conv_mat(in[IN_WO_A] + (size_t)l * AW * DM, DM, AW, 0, DM, (bf16*)(ws + W_O_A + l * 3 * MiB / 2), 0, nullptr, 1.f, scr, cw, ncw, lane, off);
    } else if (L == 2) {
        const float* kvn = in[IN_KVNORM];
        conv_mat(in[IN_WQ_B], DM, DM, 0, DM, (bf16*)(ws + W_QK_B), 0, gains + (2 * 4 + 0) * DM, QSCALE, scr, cw, ncw, lane, off);
        conv_mat(in[IN_WKVF], 2064, DM, 0, DM, (bf16*)(ws + W_QK_B) + (size_t)DM * DM, 0, kvn, 1.f, scr, cw, ncw, lane, off);
        conv_mat(in[IN_WKVF], 2064, DM, DM, DM, (bf16*)(ws + W_V_B), 0, kvn, 1.f, scr, cw, ncw, lane, off);
        conv_mat(in[IN_WO_B], DM, DM, 0, DM, (bf16*)(ws + W_O_B), 0, nullptr, 1.f, scr, cw, ncw, lane, off);
        for (int gt = cw * 64 + lane; gt < 16 * DM; gt += ncw * 64) { const int hd = gt >> 10, k = gt & 1023; ((float*)(ws + WS_WFT))[gt] = in[IN_WKVF][(size_t)k * 2064 + 2048 + hd] * kvn[k]; }
    } else {
        conv_mat(in[IN_WQ_B] + (size_t)DM * DM, DM, DM, 0, DM, (bf16*)(ws + W_Q_B1), 0, gains + (3 * 4 + 0) * DM, QSCALE, scr, cw, ncw, lane, off);
        conv_mat(in[IN_WO_B] + (size_t)DM * DM, DM, DM, 0, DM, (bf16*)(ws + W_O_B + 2 * MiB), 0, nullptr, 1.f, scr, cw, ncw, lane, off);
    }
    conv_mat(in[IN_WUP] + (size_t)l * DM * NUP, NUP, DM, 0, NUP, (bf16*)(ws + W_UP + l * 11 * MiB), 1, gains + (l * 4 + 2) * DM, 1.f, scr, cw, ncw, lane, off);
    conv_mat(in[IN_WDOWN] + (size_t)l * DFF * DM, DM, DFF, 0, DM, (bf16*)(ws + W_DN + l * 11 * MiB / 2), 0, nullptr, 1.f, scr, cw, ncw, lane, off);
}

template <int MODE>
__device__ __forceinline__ void row_phase(const float* src, const float* gain, bf16* hb, float* outf, bf16* xp1, bf16* xp2, float* rs0, float* rs1, float* rs2, bool want_perm,
                                          bool want_forget, const LAS float* wft, const float* bfg, float* flog, int gw, int NGW, int lane) {
    for (int m = gw; m < MROWS; m += NGW) {
        f32x4 v[4]; float ss = 0.f;
#pragma unroll
        for (int j = 0; j < 4; ++j) {
            if (MODE == 1) { const u32x2 w = *(const u32x2*)((const bf16*)src + (size_t)m * DM + 4 * lane + 256 * j); v[j] = (f32x4){bf_lo(w.x), bf_hi(w.x), bf_lo(w.y), bf_hi(w.y)}; }
            else v[j] = *(const f32x4*)(src + (size_t)m * DM + 4 * lane + 256 * j);
            ss += (v[j].x * v[j].x + v[j].y * v[j].y) + (v[j].z * v[j].z + v[j].w * v[j].w); }
        if (MODE == 1) {
            const float rs = 1.0f / sqrtf(wave_sum(ss) * (1.0f / DM) + RMS_EPS); ss = 0.f;
#pragma unroll
            for (int j = 0; j < 4; ++j) { const f32x4 g = *(const f32x4*)(gain + 4 * lane + 256 * j); const u32x2 hw = *(const u32x2*)(hb + (size_t)m * DM + 4 * lane + 256 * j);
                const f32x4 ho = (f32x4){bf_lo(hw.x), bf_hi(hw.x), bf_lo(hw.y), bf_hi(hw.y)};
                v[j] = ho + v[j] * rs * g; ss += (v[j].x * v[j].x + v[j].y * v[j].y) + (v[j].z * v[j].z + v[j].w * v[j].w); }
        }
        if (outf) {
#pragma unroll
            for (int j = 0; j < 4; ++j) *(f32x4*)(outf + (size_t)m * DM + 4 * lane + 256 * j) = v[j];
        } else {
            const float rs2v = 1.0f / sqrtf(wave_sum(ss) * (1.0f / DM) + RMS_EPS);
            u32x2 w[4];
#pragma unroll
            for (int j = 0; j < 4; ++j) { w[j].x = pk2(v[j].x, v[j].y); w[j].y = pk2(v[j].z, v[j].w); *(u32x2*)(hb + (size_t)m * DM + 4 * lane + 256 * j) = w[j]; }
            if (lane == 0) rs0[m] = rs2v;
            if (want_perm) {
                const int b = m / SEQ, t = m % SEQ;
                const size_t m1 = (size_t)b * SEQ + (t & 3) * 512 + (t >> 2), m2 = (size_t)b * SEQ + (t & 15) * 128 + (t >> 4);
#pragma unroll
                for (int j = 0; j < 4; ++j) { *(u32x2*)(xp1 + m1 * DM + 4 * lane + 256 * j) = w[j]; *(u32x2*)(xp2 + m2 * DM + 4 * lane + 256 * j) = w[j]; }
                if (lane == 0) { rs1[m1] = rs2v; rs2[m2] = rs2v; }
            }
            if (want_forget) {
                float mine = 0.f;
#pragma unroll 4
                for (int hd = 0; hd < 16; ++hd) { float a = 0.f;
#pragma unroll
                    for (int j = 0; j < 4; ++j) { const f32x4 wv = *(const LAS f32x4*)(wft + hd * DM + 4 * lane + 256 * j); a += (v[j].x * wv.x + v[j].y * wv.y) + (v[j].z * wv.z + v[j].w * wv.w); }
                    a = wave_sum(a); if (lane == hd) mine = a; }
                if (lane < 16) flog[(size_t)m * 16 + lane] = mine * rs2v + bfg[lane];
            }
        }
    }
}

__device__ __forceinline__ float log_sigmoid(float x) { return fminf(x, 0.f) - logf(1.0f + expf(-fabsf(x))); }
__device__ __forceinline__ void scan_unit(const float* flog, float* c2, int bh, int lane) {
    const int b = bh >> 4, hd = bh & 15; const float* fp = flog + ((size_t)b * SEQ + 32 * lane) * 16 + hd;
    float tot = 0.f;
    for (int i = 0; i < 32; ++i) tot += log_sigmoid(fp[i * 16]);
    float inc = tot;
#pragma unroll
    for (int o = 1; o < 64; o <<= 1) { const float t = __shfl_up(inc, o); if (lane >= o) inc += t; }
    float run = inc - tot;
    float* cp = c2 + (size_t)bh * SEQ + 32 * lane;
    for (int i = 0; i < 32; ++i) { run += log_sigmoid(fp[i * 16]); cp[i] = run * LOG2E; }
}

struct AttnHalf {
    const bf16* Q; const bf16* K; const bf16* VT; bf16* O; float* lse; const float* cq;
    int q_stride, k_stride, vt_pitch, o_stride, lse_stride;
    int q0, kv_begin, nback, pos0, pos_step;
};
constexpr int AT_PITCH = 144, AT_VP = 136  , AT_K = 0, AT_V = 9216, AT_CK = 18432, AT_BUF = 18688, AT_HALF = 2 * AT_BUF;
__device__ __forceinline__ int crow(int r, int hi) { return (r & 3) + 8 * (r >> 2) + 4 * hi; }
__device__ __forceinline__ void rope16v(u32x4& a, u32x4& b, const f32x4 c0, const f32x4 c1, const f32x4 s0, const f32x4 s1) {
#define RC_(k) ((k) < 4 ? c0[(k) & 3] : c1[(k) & 3])
#define RS_(k) ((k) < 4 ? s0[(k) & 3] : s1[(k) & 3])
    u32x4 oa, ob;
#pragma unroll
    for (int i = 0; i < 4; ++i) {
        const float x1l = bf_lo(a[i]), x1h = bf_hi(a[i]), x2l = bf_lo(b[i]), x2h = bf_hi(b[i]);
        oa[i] = pk2(x1l * RC_(2 * i) - x2l * RS_(2 * i), x1h * RC_(2 * i + 1) - x2h * RS_(2 * i + 1));
        ob[i] = pk2(x2l * RC_(2 * i) + x1l * RS_(2 * i), x2h * RC_(2 * i + 1) + x1h * RS_(2 * i + 1));
    }
    a = oa; b = ob;
#undef RC_
#undef RS_
}
__device__ __forceinline__ void rope16(u32x4& a, u32x4& b, const float* ct, const float* st) {
    rope16v(a, b, *(const f32x4*)ct, *(const f32x4*)(ct + 4), *(const f32x4*)st, *(const f32x4*)(st + 4));
}

__device__ __forceinline__ float xhalf_max(float v) { auto rr = __builtin_amdgcn_permlane32_swap(__float_as_uint(v), __float_as_uint(v), false, false); return fmaxf(__uint_as_float(rr[0]), __uint_as_float(rr[1])); }
__device__ __forceinline__ float xhalf_sum(float v) { auto rr = __builtin_amdgcn_permlane32_swap(__float_as_uint(v), __float_as_uint(v), false, false); return __uint_as_float(rr[0]) + __uint_as_float(rr[1]); }
template <int QB, bool ROPE, bool BIAS, int NH>
__device__ __forceinline__ void attn_super(const AttnHalf& U, int ntiles, LAS unsigned char* ldsbase, const float* ropetab, int tid) {
    const int lane = tid & 63, r32 = lane & 31, hi = lane >> 5, tidh = (NH == 2) ? (tid & 255) : tid, waveh = (NH == 2) ? ((tid >> 6) & 3) : (tid >> 6), half = (NH == 2) ? (tid >> 8) : 0;
    LAS unsigned char* lds = ldsbase + half * AT_HALF;
    const int qlo = U.q0 + waveh * 32 * QB, qhi = qlo + 32 * QB - 1;
    bf16x8 qf[QB][4]; float cqv[QB];
#pragma unroll
    for (int qb = 0; qb < QB; ++qb) {
        const int qi = qlo + 32 * qb + r32; const bf16* src = U.Q + (size_t)qi * U.q_stride;
#pragma unroll
        for (int d0 = 0; d0 < 4; ++d0) qf[qb][d0] = *(const bf16x8*)(src + 16 * d0 + 8 * hi);
        if (ROPE) { u32x4 a = *(const u32x4*)src, b = *(const u32x4*)(src + 8); const int pos = U.pos0 + qi * U.pos_step;
            rope16(a, b, ropetab + pos * 8, ropetab + SEQ * 8 + pos * 8); qf[qb][0] = __builtin_bit_cast(bf16x8, hi ? b : a); }
        cqv[qb] = BIAS ? U.cq[qi] : 0.f;
    }
    f32x16 OT[QB][2]; float mrun[QB], lrun[QB];
#pragma unroll
    for (int qb = 0; qb < QB; ++qb) { mrun[qb] = -1e30f; lrun[qb] = 0.f;
#pragma unroll
        for (int dh = 0; dh < 2; ++dh)
#pragma unroll
            for (int r = 0; r < 16; ++r) OT[qb][dh][r] = 0.f; }
    constexpr int NV = (NH == 2) ? 2 : 1;
    u32x4 krs[2][NV], vrs[2][NV]; f32x4 ckr[2];
    const int trow = (NH == 2) ? (tidh >> 2) : (tidh >> 3), tcol = (NH == 2) ? (tidh & 3) * 16 : (tidh & 7) * 8;
#define AT_LOAD(t, set) do { const int kv0_ = U.kv_begin + 64 * (t); const int kvc_ = kv0_ < 0 ? 0 : kv0_; \
        const bf16* ks_ = U.K + (size_t)(kvc_ + trow) * U.k_stride + tcol; const bf16* vs_ = U.VT + (size_t)(kvc_ >> 6) * 4096 + trow * 64 + tcol; \
        _Pragma("unroll") for (int i_ = 0; i_ < NV; ++i_) { krs[set][i_] = *(const u32x4*)(ks_ + 8 * i_); vrs[set][i_] = *(const u32x4*)(vs_ + 8 * i_); } \
        if (BIAS) { if (tidh < 16) ckr[set] = *(const f32x4*)(U.cq + kvc_ + 4 * tidh); } \
} while (0)
#define AT_STORE(buf, set) do { LAS unsigned char* b_ = lds + (buf) * AT_BUF; \
        _Pragma("unroll") for (int i_ = 0; i_ < NV; ++i_) { *(LAS u32x4*)(b_ + AT_K + trow * AT_PITCH + tcol * 2 + 16 * i_) = krs[set][i_]; \
            *(LAS u32x2*)(b_ + AT_V + trow * AT_VP + tcol * 2 + 16 * i_) = (u32x2){vrs[set][i_].x, vrs[set][i_].y}; *(LAS u32x2*)(b_ + AT_V + trow * AT_VP + tcol * 2 + 16 * i_ + 8) = (u32x2){vrs[set][i_].z, vrs[set][i_].w}; } \
        if (BIAS) { if (tidh < 16) *(LAS f32x4*)(b_ + AT_CK + 16 * tidh) = -ckr[set]; } } while (0)
#define AT_BODY(t) do { \
        const LAS unsigned char* bb = lds + ((t) & 1) * AT_BUF; \
        const int kv0 = U.kv_begin + 64 * (t); \
        if (!(kv0 + 63 < 0 || kv0 > qhi || qlo - (kv0 + 63) > U.nback)) { \
            bf16x8 kf[2][4]; \
            _Pragma("unroll") for (int kb = 0; kb < 2; ++kb) \
            _Pragma("unroll") for (int d0 = 0; d0 < 4; ++d0) kf[kb][d0] = *(const LAS bf16x8*)(bb + AT_K + (32 * kb + r32) * AT_PITCH + (16 * d0 + 8 * hi) * 2); \
            f32x16 S[QB][2]; \
            _Pragma("unroll") for (int kb = 0; kb < 2; ++kb) { \
                f32x4 ck4[4]; \
                if (BIAS) { _Pragma("unroll") for (int jj = 0; jj < 4; ++jj) ck4[jj] = *(const LAS f32x4*)(bb + AT_CK + (32 * kb + 8 * jj + 4 * hi) * 4); } \
                _Pragma("unroll") for (int qb = 0; qb < QB; ++qb) \
                _Pragma("unroll") for (int r = 0; r < 16; ++r) S[qb][kb][r] = BIAS ? ck4[r >> 2][r & 3] : 0.f; } \
            _Pragma("unroll") for (int d0 = 0; d0 < 4; ++d0) \
            _Pragma("unroll") for (int kb = 0; kb < 2; ++kb) \
            _Pragma("unroll") for (int qb = 0; qb < QB; ++qb) S[qb][kb] = __builtin_amdgcn_mfma_f32_32x32x16_bf16(kf[kb][d0], qf[qb][d0], S[qb][kb], 0, 0, 0); \
            bf16x8 pa[QB][4]; \
            _Pragma("unroll") for (int qb = 0; qb < QB; ++qb) { \
                const int qb0 = qlo + 32 * qb, qi = qb0 + r32; \
                if (kv0 + 63 > qb0 || qb0 + 31 - kv0 > U.nback) { \
                    _Pragma("unroll") for (int kb = 0; kb < 2; ++kb) \
                    _Pragma("unroll") for (int r = 0; r < 16; ++r) { const int kvj = kv0 + 32 * kb + crow(r, hi); const bool ok = (kvj <= qi) && (qi - kvj <= U.nback); S[qb][kb][r] = ok ? S[qb][kb][r] : -INFINITY; } \
                } \
                float mx0 = fmaxf(S[qb][0][0], S[qb][1][0]), mx1 = fmaxf(S[qb][0][1], S[qb][1][1]); \
                _Pragma("unroll") for (int r = 2; r < 16; r += 2) { mx0 = fmaxf(mx0, fmaxf(S[qb][0][r], S[qb][1][r])); mx1 = fmaxf(mx1, fmaxf(S[qb][0][r + 1], S[qb][1][r + 1])); } \
                const float mx = xhalf_max(fmaxf(mx0, mx1)); \
                const float mnew = fmaxf(mrun[qb], mx); \
                const float alpha = __builtin_amdgcn_exp2f(mrun[qb] - mnew); \
                if (__any(mnew > mrun[qb])) { \
                    _Pragma("unroll") for (int dh = 0; dh < 2; ++dh) \
                    _Pragma("unroll") for (int r = 0; r < 16; ++r) OT[qb][dh][r] *= alpha; \
                } \
                mrun[qb] = mnew; \
                float ps0 = 0.f, ps1 = 0.f, ps2 = 0.f, ps3 = 0.f; \
                _Pragma("unroll") for (int kb = 0; kb < 2; ++kb) { \
                    _Pragma("unroll") for (int r = 0; r < 16; ++r) S[qb][kb][r] = __builtin_amdgcn_exp2f(S[qb][kb][r] - mnew); \
                    _Pragma("unroll") for (int r = 0; r < 16; r += 4) { ps0 += S[qb][kb][r]; ps1 += S[qb][kb][r + 1]; ps2 += S[qb][kb][r + 2]; ps3 += S[qb][kb][r + 3]; } \
                    _Pragma("unroll") for (int ks = 0; ks < 2; ++ks) { u32x4 w; w.x = pk2(S[qb][kb][8 * ks], S[qb][kb][8 * ks + 1]); w.y = pk2(S[qb][kb][8 * ks + 2], S[qb][kb][8 * ks + 3]); \
                        w.z = pk2(S[qb][kb][8 * ks + 4], S[qb][kb][8 * ks + 5]); w.w = pk2(S[qb][kb][8 * ks + 6], S[qb][kb][8 * ks + 7]); pa[qb][2 * kb + ks] = __builtin_bit_cast(bf16x8, w); } \
                } \
                lrun[qb] = lrun[qb] * alpha + ((ps0 + ps1) + (ps2 + ps3)); \
            } \
            _Pragma("unroll") for (int kstep = 0; kstep < 4; ++kstep) \
            _Pragma("unroll") for (int dh = 0; dh < 2; ++dh) { \
                const LAS unsigned char* vp = bb + AT_V + (32 * dh + r32) * AT_VP + (16 * kstep + 4 * hi) * 2; \
                const s16x4 lo = *(const LAS s16x4*)vp, hi4 = *(const LAS s16x4*)(vp + 16); \
                const bf16x8 vf = (bf16x8){lo[0], lo[1], lo[2], lo[3], hi4[0], hi4[1], hi4[2], hi4[3]}; \
                _Pragma("unroll") for (int qb = 0; qb < QB; ++qb) OT[qb][dh] = __builtin_amdgcn_mfma_f32_32x32x16_bf16(vf, pa[qb][kstep], OT[qb][dh], 0, 0, 0); \
            } \
        } \
    } while (0)
    AT_LOAD(0, 0); if (ntiles > 1) AT_LOAD(1, 1);
    AT_STORE(0, 0);
    __syncthreads();
    for (int t = 0; t < ntiles; t += 2) {
        if (t + 2 < ntiles) AT_LOAD(t + 2, 0);
        AT_BODY(t);
        if (t + 1 < ntiles) AT_STORE(1, 1);
        __syncthreads();
        if (t + 1 < ntiles) {
            if (t + 3 < ntiles) AT_LOAD(t + 3, 1);
            AT_BODY(t + 1);
            if (t + 2 < ntiles) AT_STORE(0, 0);
            __syncthreads();
        }
    }
#undef AT_BODY
#undef AT_LOAD
#undef AT_STORE
    LAS unsigned char* stg = ldsbase + 2 * AT_HALF + (tid >> 6) * 4608;
#pragma unroll
    for (int qb = 0; qb < QB; ++qb) {
        const float l = xhalf_sum(lrun[qb]); const float inv = 1.0f / l;
#pragma unroll
        for (int dh = 0; dh < 2; ++dh)
#pragma unroll
            for (int r4 = 0; r4 < 4; ++r4) { u32x2 w; w.x = pk2(OT[qb][dh][4 * r4] * inv, OT[qb][dh][4 * r4 + 1] * inv); w.y = pk2(OT[qb][dh][4 * r4 + 2] * inv, OT[qb][dh][4 * r4 + 3] * inv);
                *(LAS u32x2*)(stg + r32 * 144 + (32 * dh + 8 * r4 + 4 * hi) * 2) = w; }
        asm volatile("s_waitcnt lgkmcnt(0)" ::: "memory");
#pragma unroll
        for (int i = 0; i < 4; ++i) { const int row = i * 8 + (lane >> 3), ch = lane & 7; const u32x4 v = *(const LAS u32x4*)(stg + row * 144 + ch * 16);
            *(u32x4*)(U.O + (size_t)(qlo + 32 * qb + row) * U.o_stride + ch * 8) = v; }
        asm volatile("s_waitcnt lgkmcnt(0)" ::: "memory");
        const int qi = qlo + 32 * qb + r32;
        if (U.lse && hi == 0) U.lse[(size_t)qi * U.lse_stride] = mrun[qb] + __builtin_amdgcn_logf(l);
    }
}

#define XB_TMO      128
#define XB_XCNT(j)  (256  + 64 * (j))
#define XB_XSUB(j)  (1280 + 64 * (j))
#define XB_XGEN(j)  (2304 + 64 * (j))
#define XB_TOP      3328
#define XB_TOPGEN   3392
#define XCD_BAR_WORDS 3456
#define XB_SPIN_CAP (1u << 18)

__device__ __forceinline__ unsigned xb_ld(unsigned* p)              { return __hip_atomic_load(p, __ATOMIC_RELAXED, __HIP_MEMORY_SCOPE_AGENT); }
__device__ __forceinline__ unsigned xb_add(unsigned* p, unsigned v) { return __hip_atomic_fetch_add(p, v, __ATOMIC_RELAXED, __HIP_MEMORY_SCOPE_AGENT); }
__device__ __forceinline__ unsigned xb_xcc_id() { return (unsigned)__builtin_amdgcn_s_getreg((3 << 11) | 20) & 0xFu; }
#define XB_SPIN(cond, bar) do { unsigned _sp = 0; while (cond) { __builtin_amdgcn_s_sleep(1); \
    if ((++_sp & 255u) == 0u) { if (xb_ld(&(bar)[XB_TMO])) break; if (_sp > XB_SPIN_CAP) { atomicAdd(&(bar)[XB_TMO], 1u); break; } } } } while (0)

struct XcdBarrier {
    unsigned* bar; unsigned x;
    volatile LAS unsigned* st;
};

__device__ __forceinline__ XcdBarrier xcd_barrier_post(unsigned* bar, volatile LAS unsigned* st) {
    XcdBarrier b; b.bar = bar; b.x = xb_xcc_id(); b.st = st;
    if (threadIdx.x == 0) (void)xb_add(&bar[XB_XCNT(b.x)], 1u);
    return b;
}
__device__ __forceinline__ void xcd_barrier_complete(unsigned* bar, unsigned x, unsigned& nloc, unsigned& nx) {
    const unsigned G = gridDim.x * gridDim.y * gridDim.z;
    unsigned sum, cnt, mine, sp = 0u;
    for (;;) {
        sum = 0u; cnt = 0u; mine = 0u;
#pragma unroll
        for (unsigned j = 0; j < 16; ++j) { const unsigned c = xb_ld(&bar[XB_XCNT(j)]); sum += c; cnt += (c > 0u) ? 1u : 0u; mine = (j == x) ? c : mine; }
        if (sum == G) break;
        __builtin_amdgcn_s_sleep(1);
        if ((++sp & 255u) == 0u) { if (xb_ld(&bar[XB_TMO])) break; if (sp > XB_SPIN_CAP) { atomicAdd(&bar[XB_TMO], 1u); break; } }
    }
    nloc = mine > 0u ? mine : 1u; nx = cnt > 0u ? cnt : 1u;
}

__device__ __forceinline__ void xcd_barrier(const XcdBarrier& b) {
    asm volatile("s_waitcnt vmcnt(0)" ::: "memory");
    __syncthreads();
    if (threadIdx.x == 0) {
        unsigned* bar = b.bar;
        __builtin_amdgcn_s_waitcnt(0);
        unsigned nloc = b.st[0], nx = b.st[1];
        if (nloc == 0u) { xcd_barrier_complete(bar, b.x, nloc, nx); b.st[0] = nloc; b.st[1] = nx; }
        const unsigned old = xb_add(&bar[XB_XSUB(b.x)], 1u);
        const unsigned gen = old / nloc;
        if (old + 1u == (gen + 1u) * nloc) {
            __builtin_amdgcn_fence(__ATOMIC_RELEASE, "agent");
            asm volatile("s_waitcnt vmcnt(0)" ::: "memory");
            const unsigned og = xb_add(&bar[XB_TOP], 1u);
            const unsigned tg = og / nx;
            if (og + 1u == (tg + 1u) * nx) xb_add(&bar[XB_TOPGEN], 1u);
            else XB_SPIN(xb_ld(&bar[XB_TOPGEN]) == tg, bar);
            __builtin_amdgcn_fence(__ATOMIC_ACQUIRE, "agent");
            xb_add(&bar[XB_XGEN(b.x)], 1u);
            asm volatile("s_waitcnt vmcnt(0)" ::: "memory");
        } else {
            XB_SPIN(xb_ld(&bar[XB_XGEN(b.x)]) == gen, bar);
            __builtin_amdgcn_fence(__ATOMIC_ACQUIRE, "agent");
            asm volatile("s_waitcnt vmcnt(0)" ::: "memory");
        }
    }
    __syncthreads();
}

struct Args { const float* in[13]; float* out; unsigned char* ws; float invf[8]; int ph_lo, ph_hi; };

__host__ __device__ inline bool phase_noop(int ph) { if (ph == 0) return false; const int l = (ph - 1) / 9, s = (ph - 1) % 9; return (s == 2 && l >= 2) || s == 6; }

#define PH_LOCALS() \
    int tid = threadIdx.x; asm volatile("" : "+v"(tid)); \
    const int lane = tid & 63, wave = __builtin_amdgcn_readfirstlane(tid >> 6); \
    const int G = gridDim.x, bx = blockIdx.x, gw = bx * 8 + wave, NGW = G * 8; \
    unsigned char* ws = a.ws; float* h = a.out; \
    bf16* xn = (bf16*)(ws + WS_XN); float* Fb = (float*)(ws + WS_F); \
    const float* gains = a.in[IN_GAINS]; const float* ropetab = (const float*)(ws + WS_ROPE); \
    (void)lane; (void)wave; (void)gw; (void)NGW; (void)h; (void)xn; (void)Fb; (void)gains; (void)ropetab; (void)G; (void)bx
#ifndef PROBE_REP
#define PROBE_REP 0
#endif
#ifndef PROBE_SYNC2
#define PROBE_SYNC2 0
#endif
#ifndef PROBE_LAYERS
#define PROBE_LAYERS 0xF
#endif
__host__ __device__ constexpr int phase_reps_raw(int k) { return (k == 0) ? (((PROBE_REP >> 9) & 1) ? 2 : 1) : ((((PROBE_REP >> ((k - 1) % 9)) & 1) && ((PROBE_LAYERS >> ((k - 1) / 9)) & 1)) ? 2 : 1); }
__host__ __device__ constexpr bool phase_is_gemm(int k) { return k > 0 && (((k - 1) % 9) == 0 || ((k - 1) % 9) == 3 || ((k - 1) % 9) == 5 || ((k - 1) % 9) == 7); }
__host__ __device__ constexpr int phase_reps(int k) { return phase_is_gemm(k) ? 1 : phase_reps_raw(k); }
#define PH_BEGIN(k) if (a.ph_lo <= (k) && (k) < a.ph_hi) { for (int rep_ = 0; rep_ < phase_reps(k); ++rep_) { if (rep_) grid.sync(); PH_LOCALS();
#define SEAM1(k) do { if ((k) == 0) { grid.sync(); (void)xcd_barrier_post((unsigned*)(a.ws + WS_BAR), (volatile LAS unsigned*)(lds + LDS_MISC)); } \
    else { XcdBarrier b_; b_.bar = (unsigned*)(a.ws + WS_BAR); b_.x = xb_xcc_id(); b_.st = (volatile LAS unsigned*)(lds + LDS_MISC); xcd_barrier(b_); } } while (0)
#define PH_END(k) } if ((k) + 1 < a.ph_hi) { SEAM1(k); if (PROBE_SYNC2 && (k) != 0) SEAM1(k); } }

template <int L>
__device__ __forceinline__ void run_layer(const Args& a, LAS unsigned char* lds, cg::grid_group& grid) {
    constexpr int base = 1 + 9 * L; constexpr bool isA = L < 2; constexpr int l = L;
    PH_BEGIN(base + 0)
        if (L == 2) { if (gw < BATCH * 16) scan_unit((const float*)(ws + WS_FLOG), (float*)(ws + WS_C2), gw, lane); }
        {
            pg8::Gemm g;
            if (isA) g = pg8::Gemm{xn, (const bf16*)(ws + W_QK_A + l * 3 * MiB), MROWS, 1536, DM};
            else if (L == 2) g = pg8::Gemm{xn, (const bf16*)(ws + W_QK_B), MROWS, 2048, DM};
            else g = pg8::Gemm{xn, (const bf16*)(ws + W_Q_B1), MROWS, DM, DM};
            pg8::StaticOrder S; S.init(g.M, g.N, G, bx); S.reps = phase_reps_raw(base + 0);
            pg8::EpiHeads<isA> E{isA ? (bf16*)(ws + G_QK_A) : (bf16*)(ws + G_Q_B), isA ? (bf16*)(ws + G_QK_A + 24 * MiB) : (bf16*)(ws + G_K_B), isA ? 12 : 16, ropetab, (const float*)(ws + WS_RS0)};
            pg8::gemm_phase<pg8::EpiHeads<isA>, pg8::StaticOrder, true, true>(lds, g, S, E);
            __syncthreads();
        }
        constexpr int nvt = isA ? 3 : (L == 2 ? 1 : 0);
        for (int j = 0; j < nvt; ++j) {
            pg8::Gemm g; bf16* O; int rot = 0;
            if (isA) { const bf16* Bt = (j == 0) ? xn : (j == 1) ? (const bf16*)(ws + G_XP1) : (const bf16*)(ws + G_XP2);
                g = pg8::Gemm{(const bf16*)(ws + W_V_A + l * 3 * MiB / 2) + (size_t)j * 256 * DM, Bt, 256, MROWS, DM};
                O = (bf16*)(ws + G_VT_A) + (size_t)j * 256 * MROWS; rot = (j == 0) ? 128 : (j == 1) ? 64 : 0; }
            else { g = pg8::Gemm{(const bf16*)(ws + W_V_B), xn, DM, MROWS, DM}; O = (bf16*)(ws + G_VT_B); }
            pg8::StaticOrder S; S.init(g.M, g.N, G, (bx + rot) % G); S.reps = phase_reps_raw(base + 0);
            pg8::EpiVT E{O, (const float*)(ws + (isA ? (j == 0 ? WS_RS0 : (j == 1 ? WS_RS1 : WS_RS2)) : WS_RS0))};
            pg8::gemm_phase<pg8::EpiVT, pg8::StaticOrder, true, true>(lds, g, S, E);
            __syncthreads();
        }
    PH_END(base + 0)
    PH_BEGIN(base + 1)
        if (isA) {
            for (int su = bx; su < 768; su += G) {
                const int grp = su >> 8, hu = 2 * (su & 255) + (tid >> 8);
                const int r = (grp == 0) ? 1 : (grp == 1) ? 4 : 16, Lq = SEQ / r, nqb = Lq / 128;
                const int j = hu & 3, qb = (hu >> 2) % nqb, sq = (hu >> 2) / nqb, b = sq / r, rho = sq % r, hd12 = grp * 4 + j;
                AttnHalf U;
                const size_t row0 = (size_t)b * SEQ + rho, sbase = (size_t)b * SEQ + (size_t)rho * Lq;
                U.Q = (const bf16*)(ws + G_QK_A) + ((size_t)hd12 * MROWS + sbase) * 64; U.K = (const bf16*)(ws + G_QK_A + 24 * MiB) + ((size_t)hd12 * MROWS + sbase) * 64; U.q_stride = 64; U.k_stride = 64;
                U.VT = (const bf16*)(ws + G_VT_A) + (size_t)grp * 256 * MROWS + ((size_t)j * 256 + (sbase >> 6)) * 4096; U.vt_pitch = 0;
                U.O = (bf16*)(ws + G_O_A) + row0 * AW + hd12 * 64; U.o_stride = r * AW;
                U.lse = (float*)(ws + WS_LSE) + row0 * 12 + hd12; U.lse_stride = r * 12; U.cq = nullptr;
                U.q0 = qb * 128; U.kv_begin = U.q0 - 128; U.nback = 128; U.pos0 = rho; U.pos_step = r;
                attn_super<1, false, false, 2>(U, 4, lds, ropetab, tid);
            }
        } else {
            for (int i = 0; i < 4; ++i) {
                for (int w = bx; w < 256; w += G) {
                    const int bh = w >> 1, b = bh >> 4, hd = bh & 15, s0 = (w & 1) * 2;
                    const int qb = (i == 0) ? s0 : (i == 1) ? 7 - s0 : (i == 2) ? s0 + 1 : 6 - s0;
                    AttnHalf U;
                    U.Q = (const bf16*)(ws + G_Q_B) + ((size_t)hd * MROWS + (size_t)b * SEQ) * 64; U.K = (const bf16*)(ws + G_K_B) + ((size_t)hd * MROWS + (size_t)b * SEQ) * 64; U.q_stride = 64; U.k_stride = 64;
                    U.VT = (const bf16*)(ws + G_VT_B) + ((size_t)hd * 256 + (size_t)b * (SEQ / 64)) * 4096; U.vt_pitch = 0;
                    U.O = (bf16*)(ws + G_O_B) + (size_t)b * SEQ * DM + hd * 64; U.o_stride = DM; U.lse = nullptr; U.lse_stride = 0;
                    U.cq = (const float*)(ws + WS_C2) + (size_t)(b * 16 + hd) * SEQ;
                    U.q0 = qb * 256; U.kv_begin = 0; U.nback = 1 << 30; U.pos0 = 0; U.pos_step = 0;
                    attn_super<1, false, true, 1>(U, 4 * (qb + 1), lds, ropetab, tid);
                }
            }
        }
    PH_END(base + 1)
    if (isA) {
    PH_BEGIN(base + 2)
        const float* lse = (const float*)(ws + WS_LSE); bf16* o = (bf16*)(ws + G_O_A);
        for (int idx = bx * 512 + tid; idx < MROWS * 96; idx += G * 512) {
            const int m = idx / 96, hd12 = (idx >> 3) % 12, j = hd12 & 3, grp = hd12 >> 2;
            const float l0 = lse[(size_t)m * 12 + j], l1 = lse[(size_t)m * 12 + 4 + j], l2 = lse[(size_t)m * 12 + 8 + j];
            const float mx = fmaxf(l0, fmaxf(l1, l2));
            const float e0 = __builtin_amdgcn_exp2f(l0 - mx), e1 = __builtin_amdgcn_exp2f(l1 - mx), e2 = __builtin_amdgcn_exp2f(l2 - mx);
            const float wgt = ((grp == 0) ? e0 : (grp == 1) ? e1 : e2) / (e0 + e1 + e2);
            u32x4 v = *(const u32x4*)(o + (size_t)idx * 8);
#pragma unroll
            for (int e = 0; e < 4; ++e) v[e] = pk2(bf_lo(v[e]) * wgt, bf_hi(v[e]) * wgt);
            *(u32x4*)(o + (size_t)idx * 8) = v;
        }
    PH_END(base + 2)
    }
    PH_BEGIN(base + 3)
        pg8::Gemm g;
        if (isA) g = pg8::Gemm{(const bf16*)(ws + G_O_A), (const bf16*)(ws + W_O_A + l * 3 * MiB / 2), MROWS, DM, AW};
        else g = pg8::Gemm{(const bf16*)(ws + G_O_B), (const bf16*)(ws + W_O_B + (l - 2) * 2 * MiB), MROWS, DM, DM};
        pg8::StaticOrder S; S.init(g.M, g.N, G, bx); S.reps = phase_reps_raw(base + 3);
        pg8::EpiBf16<0> E{(bf16*)Fb, DM, nullptr, 0, 0, 1.f};
        pg8::gemm_phase<pg8::EpiBf16<0>, pg8::StaticOrder, true, true>(lds, g, S, E);
    PH_END(base + 3)
    PH_BEGIN(base + 4)
        row_phase<1>(Fb, gains + (l * 4 + 1) * DM, xn, nullptr, nullptr, nullptr, (float*)(ws + WS_RS0), nullptr, nullptr, false, false, (const LAS float*)lds, nullptr, nullptr, gw, NGW, lane);
    PH_END(base + 4)
    PH_BEGIN(base + 5)
        pg8::Gemm g{xn, (const bf16*)(ws + W_UP + l * 11 * MiB), MROWS, NUP, DM};
        pg8::StaticOrder S; S.init(g.M, g.N, G, bx); S.reps = phase_reps_raw(base + 5);
        pg8::EpiConvGlu E{(bf16*)(ws + G_U), Fb, a.in[IN_CONVW] + (size_t)l * 3 * NUP, a.in[IN_CONVB] + (size_t)l * NUP, (const float*)(ws + WS_RS0)};
        pg8::gemm_phase<pg8::EpiConvGlu, pg8::StaticOrder, true, true>(lds, g, S, E);
        if (L + 1 < NLAYER) {
            const int nfull = (MROWS / 256) * (NUP / 256) % G;
            if (nfull > 0 && bx >= nfull) { __syncthreads(); convert_layer<L + 1>(a.in, ws, (LAS float*)(lds + wave * 16384), (bx - nfull) * 8 + wave, (G - nfull) * 8, lane); }
            else if (nfull == 0) { __syncthreads(); convert_layer<L + 1>(a.in, ws, (LAS float*)(lds + wave * 16384), gw, NGW, lane); }
        }
    PH_END(base + 5)
    PH_BEGIN(base + 7)
        pg8::Gemm g{(const bf16*)(ws + G_U), (const bf16*)(ws + W_DN + l * 11 * MiB / 2), MROWS, DM, DFF};
        pg8::StaticOrder S; S.init(g.M, g.N, G, bx); S.reps = phase_reps_raw(base + 7);
        {
            pg8::Unit u0;
            if (S.next(0, u0)) {
                const float* side = Fb; const float* cw = a.in[IN_CONVW] + (size_t)l * 3 * NUP; const float* cb = a.in[IN_CONVB] + (size_t)l * NUP; bf16* Ub = (bf16*)(ws + G_U);
                for (int idx = tid; idx < 4 * 2 * 704; idx += 512) {
                    const int cg4 = idx % 704, rr = (idx / 704) & 1, c = u0.pm * 4 + idx / 1408, ch = 4 * cg4; const bool first = (c % 32) == 0;
                    f32x4 o;
#pragma unroll
                    for (int hv = 0; hv < 2; ++hv) {
                        const int col = hv * DFF + ch; const f32x4 z = (f32x4){0.f, 0.f, 0.f, 0.f};
                        const f32x4 s0 = *(const f32x4*)(side + (size_t)(c * 4 + 0) * NUP + col);
                        const f32x4 p3 = first ? z : *(const f32x4*)(side + (size_t)(c * 4 - 1) * NUP + col);
                        f32x4 at, at1, at2;
                        if (rr == 0) { at = s0; at1 = p3; at2 = first ? z : *(const f32x4*)(side + (size_t)(c * 4 - 2) * NUP + col); }
                        else { at = *(const f32x4*)(side + (size_t)(c * 4 + 1) * NUP + col); at1 = s0; at2 = p3; }
                        const f32x4 r = *(const f32x4*)(cw + col) * at2 + *(const f32x4*)(cw + NUP + col) * at1 + *(const f32x4*)(cw + 2 * NUP + col) * at + *(const f32x4*)(cb + col);
                        if (hv == 0) { o.x = pg8::gelu_tanh(r.x); o.y = pg8::gelu_tanh(r.y); o.z = pg8::gelu_tanh(r.z); o.w = pg8::gelu_tanh(r.w); } else o = o * r;
                    }
                    u32x2 w; w.x = pk2(o.x, o.y); w.y = pk2(o.z, o.w);
                    *(u32x2*)(Ub + (size_t)(c * 64 + rr) * DFF + ch) = w;
                }
            }
            asm volatile("s_waitcnt vmcnt(0)" ::: "memory");
            __syncthreads();
        }
        pg8::EpiBf16<0> E{(bf16*)Fb, DM, nullptr, 0, 0, 1.f};
        pg8::gemm_phase<pg8::EpiBf16<0>, pg8::StaticOrder, true, true>(lds, g, S, E);
    PH_END(base + 7)
    PH_BEGIN(base + 8)
        constexpr bool last = (L == NLAYER - 1), forget = (L == 1);
        if (forget) { const float* wsrc = (const float*)(ws + WS_WFT); LAS float* wl = (LAS float*)lds;
            for (int i = tid; i < 16 * DM / 4; i += 512) *(LAS f32x4*)(wl + 4 * i) = *(const f32x4*)(wsrc + 4 * i);
            __syncthreads(); }
        row_phase<1>(Fb, gains + (l * 4 + 3) * DM, xn, last ? h : (float*)nullptr, (bf16*)(ws + G_XP1), (bf16*)(ws + G_XP2), (float*)(ws + WS_RS0), (float*)(ws + WS_RS1), (float*)(ws + WS_RS2), L == 0, forget, (const LAS float*)lds, a.in[IN_BF], (float*)(ws + WS_FLOG), gw, NGW, lane);
    PH_END(base + 8)
}

__global__ void __launch_bounds__(512, 2) yoco_fwd(Args a) {
    extern __shared__ __attribute__((aligned(16))) unsigned char lds_raw[];
    LAS unsigned char* lds = (LAS unsigned char*)lds_raw;
    cg::grid_group grid = cg::this_grid();
    if (threadIdx.x < 2) ((volatile LAS unsigned*)(lds + LDS_MISC))[threadIdx.x] = 0u;
    __syncthreads();
    PH_BEGIN(0)
        if (bx == 0) { unsigned* bw = (unsigned*)(ws + WS_BAR); for (int i = tid; i < XCD_BAR_WORDS; i += 512) bw[i] = 0u; }
        convert_layer<0>(a.in, ws, (LAS float*)(lds + wave * 16384), gw, NGW, lane);
        const int gt = bx * 512 + tid;
        if (gt < SEQ * 8) { const int pos = gt >> 3, i = gt & 7; float sn, cs; sincos_f64((float)pos * a.invf[i], sn, cs);
            ((float*)(ws + WS_ROPE))[gt] = cs; ((float*)(ws + WS_ROPE))[SEQ * 8 + gt] = sn; }
        row_phase<0>(a.in[IN_X], nullptr, xn, nullptr, (bf16*)(ws + G_XP1), (bf16*)(ws + G_XP2), (float*)(ws + WS_RS0), (float*)(ws + WS_RS1), (float*)(ws + WS_RS2), true, false, (const LAS float*)lds, nullptr, nullptr, gw, NGW, lane);
    PH_END(0)
    run_layer<0>(a, lds, grid);
    run_layer<1>(a, lds, grid);
    run_layer<2>(a, lds, grid);
    run_layer<3>(a, lds, grid);
}

#ifndef MK_SINGLE
#define MK_SINGLE 1
#endif
extern "C" void kernel_launch(void* const* d_in, const int* in_sizes, int n_in, void* d_out, int out_size, void* d_ws, size_t ws_size, hipStream_t stream) {
    static int grid = 0;
    if (grid == 0) {
        if (n_in != 13 || out_size != MROWS * DM || ws_size < WS_END) { fprintf(stderr, "kernel_launch: unexpected shapes (n_in %d, out %d, ws %zu)\n", n_in, out_size, ws_size); grid = -1; return; }
        int dev = 0, cus = 0, per_cu = 0;
        hipGetDevice(&dev); hipDeviceGetAttribute(&cus, hipDeviceAttributeMultiprocessorCount, dev);
        if (hipFuncSetAttribute((const void*)yoco_fwd, hipFuncAttributeMaxDynamicSharedMemorySize, LDS_BYTES) != hipSuccess) { fprintf(stderr, "kernel_launch: hipFuncSetAttribute failed\n"); grid = -1; return; }
        hipOccupancyMaxActiveBlocksPerMultiprocessor(&per_cu, (const void*)yoco_fwd, 512, LDS_BYTES);
        if (per_cu < 1) { fprintf(stderr, "kernel_launch: occupancy query says %d\n", per_cu); per_cu = 1; }
        (void)hipGetLastError();
        grid = cus * 1;
        fprintf(stderr, "kernel_launch: grid %d (per_cu %d)\n", grid, per_cu);
    }
    if (grid < 0) return;
    Args a{};
    for (int i = 0; i < 13; ++i) a.in[i] = (const float*)d_in[i];
    a.out = (float*)d_out; a.ws = (unsigned char*)d_ws;
    for (int i = 0; i < 8; ++i) a.invf[i] = powf(500000.0f, -(float)(2 * i) / 16.0f);
#if MK_SINGLE
    a.ph_lo = 0; a.ph_hi = NPHASE;
    void* args[] = {&a};
    hipError_t e = hipLaunchCooperativeKernel((const void*)yoco_fwd, dim3(grid), dim3(512), args, LDS_BYTES, stream);
    if (e != hipSuccess) fprintf(stderr, "cooperative launch failed: %s (grid %d)\n", hipGetErrorString(e), grid);
#else
    for (int ph = 0; ph < NPHASE; ++ph) {
        if (phase_noop(ph)) continue;
        a.ph_lo = ph; a.ph_hi = ph + 1;
        hipLaunchKernelGGL(yoco_fwd, dim3(grid), dim3(512), LDS_BYTES, stream, a);
    }
#endif
}
```
